# Optimizing an MI355X kernel written in HIP

```python
import math
import jax
import jax.numpy as jnp
from jax import lax
import numpy as np


D_MODEL = 1024
BATCH = 8
SEQ = 2048
DEPTH = 4

GRID_W = 64
CTX_LEN = 256
N_MIXERS = 3
HEAD_DIM = 64
ROPE_QUARTER = HEAD_DIM // 4
ROPE_BASE = 10000.0
EPS = 1e-6
NEG = -1e30
DA_HEADS = 8
DA_HEAD_DIM = HEAD_DIM
DA_IN_DIM = 3 * DA_HEADS * 2 * DA_HEAD_DIM
Q_BLOCK = 128
ML_HEADS = 8
ML_QK_DIM = 64
ML_V_DIM = D_MODEL // ML_HEADS
ML_CHUNK = 64
ML_FORGET_BIAS = 3.0
ML_IN_DIM = 2 * ML_HEADS * ML_QK_DIM + 2 * ML_HEADS * ML_V_DIM + 4 * ML_HEADS
SW_Q_HEADS = 16
SW_KV_HEADS = 4
SW_HEAD_DIM = HEAD_DIM
SW_WINDOW = 128
SW_BLOCK = 128
SW_IN_DIM = (SW_Q_HEADS + 2 * SW_KV_HEADS) * SW_HEAD_DIM
FFN_DIM = 2816
FFN_CONV = 3

kernel_name = 'hybrid_diffusion_interleaved_block'


def rmsnorm(x, g):
    xf = x.astype(jnp.float32)
    y = xf * lax.rsqrt(jnp.mean(xf * xf, axis=-1, keepdims=True) + EPS)
    return (y * g.astype(jnp.float32)).astype(x.dtype)


def modulate(h, shift, scale):
    return h * (1.0 + scale) + shift


def axial_rope_tables(n_tokens):
    rows = n_tokens // GRID_W
    row = jnp.repeat(jnp.arange(rows, dtype=jnp.float32), GRID_W)
    col = jnp.tile(jnp.arange(GRID_W, dtype=jnp.float32), rows)
    inv = ROPE_BASE ** (-jnp.arange(ROPE_QUARTER, dtype=jnp.float32) / ROPE_QUARTER)
    ang_r = row[:, None] * inv
    ang_c = col[:, None] * inv
    return (jnp.cos(ang_r)[:, None, :], jnp.sin(ang_r)[:, None, :],
            jnp.cos(ang_c)[:, None, :], jnp.sin(ang_c)[:, None, :])


def rope_half(x, cos, sin):
    x1, x2 = jnp.split(x, 2, axis=-1)
    cos = cos.astype(x.dtype)
    sin = sin.astype(x.dtype)
    return jnp.concatenate([x1 * cos - x2 * sin, x2 * cos + x1 * sin], axis=-1)


def apply_axial_rope(x, rope):
    cr, sr, cc, sc = rope
    half = x.shape[-1] // 2
    return jnp.concatenate([rope_half(x[..., :half], cr, sr), rope_half(x[..., half:], cc, sc)], axis=-1)


def diff_core(q, k, v, lam):
    s = jnp.einsum('bqhcd,bkhcd->bhcqk', q, k).astype(jnp.float32) * (DA_HEAD_DIM ** -0.5)
    p = jax.nn.softmax(s, axis=-1)
    w = p[:, :, 0] - lam * p[:, :, 1]
    return jnp.einsum('bhqk,bkhe->bqhe', w.astype(v.dtype), v)


def diff_attention(h_lat, h_ctx, w_in, lam_q1, lam_k1, lam_q2, lam_k2, subln_g, w_out, layer_idx, rope, need_ctx):
    f32 = jnp.float32
    lam_init = 0.8 - 0.6 * math.exp(-0.3 * layer_idx)
    lam = (jnp.exp(jnp.sum(lam_q1.astype(f32) * lam_k1.astype(f32)))
           - jnp.exp(jnp.sum(lam_q2.astype(f32) * lam_k2.astype(f32))) + lam_init)

    def project(h, use_rope):
        b, t, _ = h.shape
        q, k, v = jnp.split(h @ w_in, 3, axis=-1)
        q = q.reshape(b, t, 2 * DA_HEADS, DA_HEAD_DIM)
        k = k.reshape(b, t, 2 * DA_HEADS, DA_HEAD_DIM)
        if use_rope:
            q = apply_axial_rope(q, rope)
            k = apply_axial_rope(k, rope)
        return (q.reshape(b, t, DA_HEADS, 2, DA_HEAD_DIM),
                k.reshape(b, t, DA_HEADS, 2, DA_HEAD_DIM),
                v.reshape(b, t, DA_HEADS, 2 * DA_HEAD_DIM))

    def finish(o):
        b, t = o.shape[:2]
        return (rmsnorm(o, subln_g) * (1.0 - lam_init)).reshape(b, t, -1) @ w_out

    ql, kl, vl = project(h_lat, True)
    qc, kc, vc = project(h_ctx, False)
    k_all = jnp.concatenate([kc, kl], axis=1)
    v_all = jnp.concatenate([vc, vl], axis=1)
    b, s = h_lat.shape[:2]
    nb = s // Q_BLOCK
    q_blocks = jnp.moveaxis(ql.reshape(b, nb, Q_BLOCK, DA_HEADS, 2, DA_HEAD_DIM), 1, 0)
    o_blocks = lax.map(lambda qb: diff_core(qb, k_all, v_all, lam), q_blocks)
    o_lat = jnp.moveaxis(o_blocks, 0, 1).reshape(b, s, DA_HEADS, 2 * DA_HEAD_DIM)
    out_ctx = finish(diff_core(qc, kc, vc, lam)) if need_ctx else None
    return finish(o_lat), out_ctx


def mlstm_chunkwise(q, k, v, ig, lf, state):
    b, h, t, _ = q.shape
    nc = t // ML_CHUNK

    def to_chunks(a):
        return jnp.moveaxis(a.reshape(a.shape[:2] + (nc, ML_CHUNK) + a.shape[3:]), 2, 0)

    tril = jnp.tril(jnp.ones((ML_CHUNK, ML_CHUNK), dtype=bool))

    def step(carry, xs):
        c_prev, n_prev, m_prev = carry
        qc, kc, vc, ic, fc = xs
        bcum = jnp.cumsum(fc, axis=-1)
        dmat = jnp.where(tril, bcum[..., :, None] - bcum[..., None, :] + ic[..., None, :], -jnp.inf)
        m_t = jnp.maximum(bcum + m_prev[..., None], jnp.max(dmat, axis=-1))
        inter = jnp.exp(bcum + m_prev[..., None] - m_t)
        s = jnp.einsum('bhtd,bhsd->bhts', qc, kc) * jnp.exp(dmat - m_t[..., None])
        num = inter[..., None] * jnp.einsum('bhed,bhtd->bhte', c_prev, qc) + jnp.einsum('bhts,bhse->bhte', s, vc)
        den = inter * jnp.einsum('bhd,bhtd->bht', n_prev, qc) + jnp.sum(s, axis=-1)
        h_out = num / jnp.maximum(jnp.abs(den), jnp.exp(-m_t))[..., None]
        m_new = m_t[..., -1]
        g = jnp.exp(bcum[..., -1:] - bcum + ic - m_new[..., None])
        decay = jnp.exp(bcum[..., -1] + m_prev - m_new)
        c_new = decay[..., None, None] * c_prev + jnp.einsum('bhs,bhse,bhsd->bhed', g, vc, kc)
        n_new = decay[..., None] * n_prev + jnp.einsum('bhs,bhsd->bhd', g, kc)
        return (c_new, n_new, m_new), h_out

    state, hs = lax.scan(step, state, (to_chunks(q), to_chunks(k), to_chunks(v), to_chunks(ig), to_chunks(lf)))
    return jnp.moveaxis(hs, 0, 2).reshape(b, h, t, v.shape[-1]), state


def mlstm_mixer(h_lat, h_ctx, w_in, gate_b, norm_g, w_out, need_ctx):
    f32 = jnp.float32
    nqk = ML_HEADS * ML_QK_DIM
    nv = ML_HEADS * ML_V_DIM

    def project(h):
        b, t, _ = h.shape
        y = h @ w_in
        heads = lambda a, d: jnp.swapaxes(a.reshape(b, t, ML_HEADS, d), 1, 2).astype(f32)
        q = heads(y[..., :nqk], ML_QK_DIM) * (ML_QK_DIM ** -0.5)
        k = heads(y[..., nqk:2 * nqk], ML_QK_DIM)
        v = heads(y[..., 2 * nqk:2 * nqk + nv], ML_V_DIM)
        o = y[..., 2 * nqk + nv:2 * nqk + 2 * nv]
        g = (y[..., 2 * nqk + 2 * nv:] + gate_b).astype(f32).reshape(b, t, 4, ML_HEADS)
        g = jnp.moveaxis(g, 1, 3)
        return (q, k, v, o, g[:, 0], jax.nn.log_sigmoid(g[:, 1]), g[:, 2], jax.nn.log_sigmoid(g[:, 3]))

    def finish(hsum, o):
        b, t = o.shape[:2]
        hh = rmsnorm(jnp.swapaxes(hsum, 1, 2).astype(o.dtype), norm_g.reshape(ML_HEADS, ML_V_DIM))
        hh = hh * jax.nn.sigmoid(o).reshape(b, t, ML_HEADS, ML_V_DIM)
        return hh.reshape(b, t, nv) @ w_out

    rev = lambda a: jnp.flip(a, axis=2)
    qc, kc, vc, oc, icf, lcf, icb, lcb = project(h_ctx)
    ql, kl, vl, ol, ilf, llf, ilb, llb = project(h_lat)
    b = h_lat.shape[0]
    state0 = (jnp.zeros((b, ML_HEADS, ML_V_DIM, ML_QK_DIM), f32),
              jnp.zeros((b, ML_HEADS, ML_QK_DIM), f32),
              jnp.zeros((b, ML_HEADS), f32))
    hcf, st_f = mlstm_chunkwise(qc, kc, vc, icf, lcf, state0)
    hlf, _ = mlstm_chunkwise(ql, kl, vl, ilf, llf, st_f)
    hcb, st_b = mlstm_chunkwise(rev(qc), rev(kc), rev(vc), rev(icb), rev(lcb), state0)
    hlb, _ = mlstm_chunkwise(rev(ql), rev(kl), rev(vl), rev(ilb), rev(llb), st_b)
    out_lat = finish(hlf + rev(hlb), ol)
    out_ctx = finish(hcf + rev(hcb), oc) if need_ctx else None
    return out_lat, out_ctx


def sink_attention(q, k, v, sink_f, mask):
    s = jnp.einsum('bqhgd,bkhd->bhgqk', q, k).astype(jnp.float32) * (SW_HEAD_DIM ** -0.5)
    if mask is not None:
        s = jnp.where(mask[None, None, None], s, NEG)
    sink_col = jnp.broadcast_to(sink_f[None, :, :, None, None], s.shape[:-1] + (1,))
    p = jax.nn.softmax(jnp.concatenate([s, sink_col], axis=-1), axis=-1)[..., :-1]
    return jnp.einsum('bhgqk,bkhd->bqhgd', p.astype(v.dtype), v)


def swa_attention(h_lat, h_ctx, w_in, sink, w_out, rope, need_ctx):
    hq, hkv, dh = SW_Q_HEADS, SW_KV_HEADS, SW_HEAD_DIM
    grp = hq // hkv
    sink_f = sink.astype(jnp.float32).reshape(hkv, grp)

    def project(h):
        b, t, _ = h.shape
        y = h @ w_in
        q = y[..., :hq * dh].reshape(b, t, hq, dh)
        k = y[..., hq * dh:(hq + hkv) * dh].reshape(b, t, hkv, dh)
        v = y[..., (hq + hkv) * dh:].reshape(b, t, hkv, dh)
        return q, k, v

    ql, kl, vl = project(h_lat)
    ql = apply_axial_rope(ql, rope)
    kl = apply_axial_rope(kl, rope)
    qc, kc, vc = project(h_ctx)
    b, s = h_lat.shape[:2]
    n_ctx = kc.shape[1]
    nb = s // SW_BLOCK

    def band(a):
        ap = jnp.pad(a, ((0, 0), (SW_BLOCK, SW_BLOCK), (0, 0), (0, 0))).reshape(b, nb + 2, SW_BLOCK, hkv, dh)
        return jnp.moveaxis(jnp.concatenate([ap[:, :-2], ap[:, 1:-1], ap[:, 2:]], axis=2), 1, 0)

    kb, vb = band(kl), band(vl)
    qb = jnp.moveaxis(ql.reshape(b, nb, SW_BLOCK, hkv, grp, dh), 1, 0)
    start = jnp.arange(nb)[:, None] * SW_BLOCK
    qpos = start + jnp.arange(SW_BLOCK)[None]
    kpos = start - SW_BLOCK + jnp.arange(3 * SW_BLOCK)[None]
    band_mask = ((jnp.abs(qpos[:, :, None] - kpos[:, None, :]) <= SW_WINDOW)
                 & (kpos[:, None, :] >= 0) & (kpos[:, None, :] < s))
    ctx_mask = jnp.ones((nb, SW_BLOCK, n_ctx), dtype=bool)
    full_mask = jnp.concatenate([ctx_mask, band_mask], axis=-1)

    def block(args):
        q_j, k_j, v_j, m_j = args
        return sink_attention(q_j, jnp.concatenate([kc, k_j], axis=1), jnp.concatenate([vc, v_j], axis=1), sink_f, m_j)

    o = lax.map(block, (qb, kb, vb, full_mask))
    out_lat = jnp.moveaxis(o, 0, 1).reshape(b, s, hq * dh) @ w_out
    out_ctx = None
    if need_ctx:
        oc = sink_attention(qc.reshape(b, n_ctx, hkv, grp, dh), kc, vc, sink_f, None)
        out_ctx = oc.reshape(b, n_ctx, hq * dh) @ w_out
    return out_lat, out_ctx


def conv_ffn(h, w_up, conv_w, conv_b, w_down):
    u = h @ w_up
    t = u.shape[1]
    pad = (FFN_CONV - 1) // 2
    up = jnp.pad(u, ((0, 0), (pad, pad), (0, 0)))
    u = conv_b + sum(up[:, j:j + t] * conv_w[j] for j in range(FFN_CONV))
    a, g = jnp.split(u, 2, axis=-1)
    return (a * jax.nn.silu(g)) @ w_down


def setup_inputs(seed: int = 0) -> dict:
    key = jax.random.key(seed)
    keys = iter(jax.random.split(key, 128))
    f32 = jnp.float32

    def normal(shape, scale=1.0):
        return scale * jax.random.normal(next(keys), shape, f32)

    def dense(fan_in, fan_out, gain=1.0):
        return normal((fan_in, fan_out), gain * fan_in ** -0.5)

    def norm_gain(n):
        return 1.0 + normal((n,), 0.1)

    def bias(n):
        return normal((n,), 0.02)

    d = D_MODEL
    inputs = {
        'x': normal((BATCH, SEQ, d)),
        'c': normal((BATCH, d)),
        'ctx': normal((BATCH, CTX_LEN, d)),
        'c_ctx': normal((d,)),
    }
    for i in range(DEPTH):
        p = 'l%d_' % i
        kind = i % N_MIXERS
        inputs[p + 'ada_w'] = dense(d, 6 * d, 0.5)
        inputs[p + 'ada_b'] = bias(6 * d)
        inputs[p + 'norm1_g'] = norm_gain(d)
        if kind == 0:
            inputs[p + 'da_w_in'] = dense(d, DA_IN_DIM)
            for nm in ('q1', 'k1', 'q2', 'k2'):
                inputs[p + 'da_lam_' + nm] = normal((DA_HEAD_DIM,), 0.1)
            inputs[p + 'da_subln_g'] = norm_gain(2 * DA_HEAD_DIM)
            inputs[p + 'da_w_out'] = dense(d, d)
        elif kind == 1:
            inputs[p + 'ml_w_in'] = dense(d, ML_IN_DIM)
            forget_offset = jnp.tile(jnp.repeat(jnp.array([0.0, ML_FORGET_BIAS], f32), ML_HEADS), 2)
            inputs[p + 'ml_gate_b'] = forget_offset + normal((4 * ML_HEADS,), 0.1)
            inputs[p + 'ml_norm_g'] = norm_gain(ML_HEADS * ML_V_DIM)
            inputs[p + 'ml_w_out'] = dense(ML_HEADS * ML_V_DIM, d)
        else:
            inputs[p + 'sw_w_in'] = dense(d, SW_IN_DIM)
            inputs[p + 'sw_sink'] = normal((SW_Q_HEADS,), 0.5)
            inputs[p + 'sw_w_out'] = dense(SW_Q_HEADS * SW_HEAD_DIM, d)
        inputs[p + 'norm2_g'] = norm_gain(d)
        inputs[p + 'ffn_w_up'] = dense(d, 2 * FFN_DIM)
        inputs[p + 'ffn_conv_w'] = normal((FFN_CONV, 2 * FFN_DIM), FFN_CONV ** -0.5)
        inputs[p + 'ffn_conv_b'] = bias(2 * FFN_DIM)
        inputs[p + 'ffn_w_down'] = dense(FFN_DIM, d)
    inputs['final_norm_g'] = norm_gain(d)
    return inputs


def reference(x, c, ctx, c_ctx,
              l0_ada_w, l0_ada_b, l0_norm1_g, l0_da_w_in, l0_da_lam_q1, l0_da_lam_k1, l0_da_lam_q2, l0_da_lam_k2,
              l0_da_subln_g, l0_da_w_out, l0_norm2_g, l0_ffn_w_up, l0_ffn_conv_w, l0_ffn_conv_b, l0_ffn_w_down,
              l1_ada_w, l1_ada_b, l1_norm1_g, l1_ml_w_in, l1_ml_gate_b, l1_ml_norm_g, l1_ml_w_out,
              l1_norm2_g, l1_ffn_w_up, l1_ffn_conv_w, l1_ffn_conv_b, l1_ffn_w_down,
              l2_ada_w, l2_ada_b, l2_norm1_g, l2_sw_w_in, l2_sw_sink, l2_sw_w_out,
              l2_norm2_g, l2_ffn_w_up, l2_ffn_conv_w, l2_ffn_conv_b, l2_ffn_w_down,
              l3_ada_w, l3_ada_b, l3_norm1_g, l3_da_w_in, l3_da_lam_q1, l3_da_lam_k1, l3_da_lam_q2, l3_da_lam_k2,
              l3_da_subln_g, l3_da_w_out, l3_norm2_g, l3_ffn_w_up, l3_ffn_conv_w, l3_ffn_conv_b, l3_ffn_w_down,
              final_norm_g):
    layers = (
        (l0_ada_w, l0_ada_b, l0_norm1_g,
         (l0_da_w_in, l0_da_lam_q1, l0_da_lam_k1, l0_da_lam_q2, l0_da_lam_k2, l0_da_subln_g, l0_da_w_out),
         l0_norm2_g, (l0_ffn_w_up, l0_ffn_conv_w, l0_ffn_conv_b, l0_ffn_w_down)),
        (l1_ada_w, l1_ada_b, l1_norm1_g,
         (l1_ml_w_in, l1_ml_gate_b, l1_ml_norm_g, l1_ml_w_out),
         l1_norm2_g, (l1_ffn_w_up, l1_ffn_conv_w, l1_ffn_conv_b, l1_ffn_w_down)),
        (l2_ada_w, l2_ada_b, l2_norm1_g,
         (l2_sw_w_in, l2_sw_sink, l2_sw_w_out),
         l2_norm2_g, (l2_ffn_w_up, l2_ffn_conv_w, l2_ffn_conv_b, l2_ffn_w_down)),
        (l3_ada_w, l3_ada_b, l3_norm1_g,
         (l3_da_w_in, l3_da_lam_q1, l3_da_lam_k1, l3_da_lam_q2, l3_da_lam_k2, l3_da_subln_g, l3_da_w_out),
         l3_norm2_g, (l3_ffn_w_up, l3_ffn_conv_w, l3_ffn_conv_b, l3_ffn_w_down)),
    )
    rope = axial_rope_tables(x.shape[1])
    for i in range(DEPTH):
        ada_w, ada_b, norm1_g, mix, norm2_g, ffn = layers[i]
        kind = i % N_MIXERS
        need_ctx = i < DEPTH - 1
        mod_l = jnp.split((jax.nn.silu(c) @ ada_w + ada_b)[:, None, :], 6, axis=-1)
        mod_c = jnp.split((jax.nn.silu(c_ctx) @ ada_w + ada_b)[None, None, :], 6, axis=-1)
        h_lat = modulate(rmsnorm(x, norm1_g), mod_l[0], mod_l[1])
        h_ctx = modulate(rmsnorm(ctx, norm1_g), mod_c[0], mod_c[1])
        if kind == 0:
            o_lat, o_ctx = diff_attention(h_lat, h_ctx, *mix, i, rope, need_ctx)
        elif kind == 1:
            o_lat, o_ctx = mlstm_mixer(h_lat, h_ctx, *mix, need_ctx)
        else:
            o_lat, o_ctx = swa_attention(h_lat, h_ctx, *mix, rope, need_ctx)
        x = x + mod_l[2] * o_lat
        x = x + mod_l[5] * conv_ffn(modulate(rmsnorm(x, norm2_g), mod_l[3], mod_l[4]), *ffn)
        if need_ctx:
            ctx = ctx + mod_c[2] * o_ctx
            ctx = ctx + mod_c[5] * conv_ffn(modulate(rmsnorm(ctx, norm2_g), mod_c[3], mod_c[4]), *ffn)
    return rmsnorm(x, final_norm_g)
```

```cpp
#include <hip/hip_runtime.h>
#include <hip/hip_cooperative_groups.h>
#include <cstdio>
#include <type_traits>
namespace cg = cooperative_groups;

#ifndef MK_ONE_LAUNCH
#define MK_ONE_LAUNCH 1
#endif

#define DI __device__ __forceinline__
typedef float f32x2 __attribute__((ext_vector_type(2)));
typedef float f32x16 __attribute__((ext_vector_type(16)));
typedef unsigned u32x2 __attribute__((ext_vector_type(2)));
typedef __bf16 bf16x2_t __attribute__((ext_vector_type(2)));

namespace pg8 {
#define PG8_LAS __attribute__((address_space(3)))
typedef unsigned short bf16_t;
typedef short bf16x8 __attribute__((ext_vector_type(8)));
typedef float f32x4 __attribute__((ext_vector_type(4)));
typedef unsigned u32x4 __attribute__((ext_vector_type(4)));
constexpr int BM = 256, BK = 64, HALF = 128, HTB = HALF * BK * 2  , STAGE_BYTES = 8 * HTB, NXCD = 8, WGM = 8;

__host__ __device__ __forceinline__ int lds_byte(int r, int c) { const int st = (r >> 4) * 2 + (c >> 5), rr = r & 15, cc = c & 31, ob = rr * 64 + cc * 2; return st * 1024 + (ob ^ (((ob >> 9) & 1) << 5)); }
__host__ __device__ __forceinline__ void stage_rc(int b, int& R, int& C) { const int st = b / 1024, sb = b % 1024, swz = sb ^ (((sb >> 9) & 1) << 5); R = (st >> 1) * 16 + swz / 64; C = (st & 1) * 32 + (swz % 64) / 2; }
__host__ __device__ __forceinline__ int perm32(int rho) { const int n = rho >> 4, i = rho & 15; return 8 * (i >> 2) + 4 * n + (i & 3); }

struct Unit { int pm, pn; };
struct Gemm { const bf16_t* A; const bf16_t* Bt; int M, N, K; };

struct StaticOrder {
    int nM, nN, nwg, G, c;
    __host__ __device__ void init(int M, int N, int G_, int c_) { nM = M / BM; nN = N / BM; nwg = nM * nN; G = G_; c = c_; }
    __host__ __device__ bool next(int i, Unit& u) const {
        const long L = (long)i * G + c; if (L >= nwg) return false;
        int wgid = (int)L; { const int q = nwg / NXCD, r = nwg % NXCD, xcd = wgid % NXCD, off = wgid / NXCD; wgid = (xcd < r ? xcd * (q + 1) : r * (q + 1) + (xcd - r) * q) + off; }
        const int nig = WGM * nN, gid = wgid / nig, fm = gid * WGM, gsz = (nM - fm) < WGM ? (nM - fm) : WGM;
        u.pm = fm + ((wgid % nig) % gsz); u.pn = (wgid % nig) / gsz; return true;
    }
    __device__ __forceinline__ void a_ready(const Unit&) const {}
    __device__ __forceinline__ void done(const Unit&) const {}
};

template <class Epi, class Sched>
__device__ __forceinline__ void gemm_phase(PG8_LAS unsigned char* lds, const Gemm g, const Sched& S, const Epi& E) {
    int tid = threadIdx.x; asm volatile("" : "+v"(tid)); const int wid = __builtin_amdgcn_readfirstlane(tid >> 6), wr = wid >> 2, wc = wid & 3;
    const int K = g.K, nt = K / BK;
    const size_t kstep = (size_t)(BK * 2);
    const size_t hstep = (size_t)HALF * K * 2;
    const size_t tstep = 2 * hstep;
    const unsigned ldsw = (unsigned)wid * 1024u;
    unsigned voffA[2], voffB[2]; int aoff, boff;
#define PG8_DERIVE() do { int t_ = tid; asm volatile("" : "+v"(t_)); const int ln_ = t_ & 63, fr_ = ln_ & 15, fq_ = ln_ >> 4; \
        _Pragma("unroll") for (int i = 0; i < 2; ++i) { int R, C; stage_rc(t_ * 16 + i * 8192, R, C); const int Rb = Epi::PERM ? ((R & ~31) + perm32(R & 31)) : R; \
            voffA[i] = (unsigned)(R * K + C) * 2u; voffB[i] = (unsigned)(Rb * K + C) * 2u; } \
        aoff = lds_byte(wr * 64 + fr_, fq_ * 8); boff = lds_byte(wc * 32 + fr_, fq_ * 8); } while (0)
    PG8_DERIVE();
#define PG8_SA(b, h) (((b) * 2 + (h)) * HTB)
#define PG8_SB(b, h) ((4 + (b) * 2 + (h)) * HTB)
#define PG8_STAGE(bufoff, gbase, voff) do { _Pragma("unroll") for (int _i = 0; _i < 2; ++_i) \
        __builtin_amdgcn_global_load_lds((const unsigned*)((const char*)(gbase) + (voff)[_i]), (PG8_LAS unsigned*)(lds + (bufoff) + ldsw + _i * 8192), 16, 0, 0); } while (0)
#define PG8_LDA(dst, b, h) do { _Pragma("unroll") for (int m = 0; m < 4; ++m) _Pragma("unroll") for (int k = 0; k < 2; ++k) dst[m][k] = *(const PG8_LAS bf16x8*)(lds + PG8_SA(b, h) + aoff + m * 2048 + k * 1024); } while (0)
#define PG8_LDB(dst, b, h) do { _Pragma("unroll") for (int n = 0; n < 2; ++n) _Pragma("unroll") for (int k = 0; k < 2; ++k) dst[n][k] = *(const PG8_LAS bf16x8*)(lds + PG8_SB(b, h) + boff + n * 2048 + k * 1024); } while (0)
#define PG8_MMA(ai, bj, At, Bt) do { __builtin_amdgcn_s_setprio(1); _Pragma("unroll") for (int m = 0; m < 4; ++m) _Pragma("unroll") for (int n = 0; n < 2; ++n) _Pragma("unroll") for (int k = 0; k < 2; ++k) \
        acc[ai][bj][m][n] = __builtin_amdgcn_mfma_f32_16x16x32_bf16(Bt[n][k], At[m][k], acc[ai][bj][m][n], 0, 0, 0); __builtin_amdgcn_s_setprio(0); } while (0)
#define PG8_WAIT_V(n) asm volatile("s_waitcnt vmcnt(" #n ")" ::: "memory")
#define PG8_WAIT_L(n) asm volatile("s_waitcnt lgkmcnt(" #n ")" ::: "memory")
#define PG8_BAR __builtin_amdgcn_s_barrier()
#define PG8_SCHED __builtin_amdgcn_sched_barrier(0)
    Unit cur, nxt; int ui = 0;
    if (!S.next(0, cur)) return;
    f32x4 acc[2][2][4][2];
#pragma unroll
    for (int a = 0; a < 2; ++a)
#pragma unroll
        for (int b = 0; b < 2; ++b)
#pragma unroll
            for (int m = 0; m < 4; ++m)
#pragma unroll
                for (int n = 0; n < 2; ++n) acc[a][b][m][n] = (f32x4){0.f, 0.f, 0.f, 0.f};
    bf16x8 At[4][2], B0[2][2], B1[2][2];
    const char* cA = (const char*)g.A + (size_t)cur.pm * tstep; const char* cB = (const char*)g.Bt + (size_t)cur.pn * tstep;
    S.a_ready(cur);
    PG8_STAGE(PG8_SB(0, 0), cB, voffB); PG8_STAGE(PG8_SA(0, 0), cA, voffA); PG8_STAGE(PG8_SB(0, 1), cB + hstep, voffB); PG8_STAGE(PG8_SA(0, 1), cA + hstep, voffA);
    if (wr == 1) PG8_BAR;
    PG8_WAIT_V(4); PG8_BAR;
    PG8_STAGE(PG8_SB(1, 0), cB + kstep, voffB); PG8_STAGE(PG8_SA(1, 0), cA + kstep, voffA); PG8_STAGE(PG8_SB(1, 1), cB + hstep + kstep, voffB);
    PG8_WAIT_V(6); PG8_BAR;
    for (;;) {
        const bool has_next = S.next(ui + 1, nxt);
        const char* nA = has_next ? (const char*)g.A + (size_t)nxt.pm * tstep : cA; const char* nB = has_next ? (const char*)g.Bt + (size_t)nxt.pn * tstep : cB;
        for (int t = 0; t < nt; t += 2) {
            const bool last = (t == nt - 2);
            const char* a1 = cA + (size_t)(t + 1) * kstep;
            const char* a2 = last ? nA : cA + (size_t)(t + 2) * kstep; const char* b2 = last ? nB : cB + (size_t)(t + 2) * kstep;
            const char* a3 = a2 + kstep; const char* b3 = b2 + kstep;
            if (last && has_next) S.a_ready(nxt);
            PG8_LDB(B0, 0, 0); PG8_SCHED; PG8_LDA(At, 0, 0); PG8_STAGE(PG8_SA(1, 1), a1 + hstep, voffA);
            PG8_WAIT_L(8); PG8_BAR; PG8_WAIT_L(0); PG8_MMA(0, 0, At, B0); PG8_BAR; PG8_SCHED;
            PG8_LDB(B1, 0, 1); PG8_STAGE(PG8_SB(0, 0), b2, voffB);
            PG8_BAR; PG8_WAIT_L(0); PG8_MMA(0, 1, At, B1); PG8_BAR;
            PG8_LDA(At, 0, 1); PG8_STAGE(PG8_SA(0, 0), a2, voffA);
            PG8_BAR; PG8_WAIT_L(0); PG8_MMA(1, 0, At, B0); PG8_BAR; PG8_SCHED;
            PG8_STAGE(PG8_SB(0, 1), b2 + hstep, voffB);
            PG8_WAIT_V(6); PG8_BAR; PG8_MMA(1, 1, At, B1); PG8_BAR;
            PG8_LDB(B0, 1, 0); PG8_SCHED; PG8_LDA(At, 1, 0); PG8_STAGE(PG8_SA(0, 1), a2 + hstep, voffA);
            PG8_WAIT_L(8); PG8_BAR; PG8_WAIT_L(0); PG8_MMA(0, 0, At, B0); PG8_BAR; PG8_SCHED;
            PG8_LDB(B1, 1, 1); PG8_STAGE(PG8_SB(1, 0), b3, voffB);
            PG8_BAR; PG8_WAIT_L(0); PG8_MMA(0, 1, At, B1); PG8_BAR;
            PG8_LDA(At, 1, 1); PG8_STAGE(PG8_SA(1, 0), a3, voffA);
            PG8_BAR; PG8_WAIT_L(0); PG8_MMA(1, 0, At, B0); PG8_BAR; PG8_SCHED;
            PG8_STAGE(PG8_SB(1, 1), b3 + hstep, voffB);
            PG8_WAIT_V(6); PG8_BAR; PG8_MMA(1, 1, At, B1); PG8_BAR;
        }
        if constexpr (!Epi::AFTER_DRAIN) { { int t_ = tid; asm volatile("" : "+v"(t_)); const int ln_ = t_ & 63; E(acc, cur, wr, wc, ln_ & 15, ln_ >> 4); } S.done(cur); PG8_DERIVE(); }
        if (!has_next) break;
#pragma unroll
        for (int a = 0; a < 2; ++a)
#pragma unroll
            for (int b = 0; b < 2; ++b)
#pragma unroll
                for (int m = 0; m < 4; ++m)
#pragma unroll
                    for (int n = 0; n < 2; ++n) acc[a][b][m][n] = (f32x4){0.f, 0.f, 0.f, 0.f};
        cur = nxt; cA = nA; cB = nB; ++ui;
    }
    PG8_WAIT_V(0);
    if (wr == 0) PG8_BAR;
    PG8_BAR;
    if constexpr (Epi::AFTER_DRAIN) { const int lane = tid & 63; E.fused(acc, cur, wr, wc, lane & 15, lane >> 4, lds, wid, lane); S.done(cur); }
#undef PG8_SA
#undef PG8_DERIVE
#undef PG8_SB
#undef PG8_STAGE
#undef PG8_LDA
#undef PG8_LDB
#undef PG8_MMA
#undef PG8_WAIT_V
#undef PG8_WAIT_L
#undef PG8_BAR
#undef PG8_SCHED
}
}

using pg8::bf16_t; using pg8::bf16x8; using pg8::f32x4; using pg8::u32x4;
#define LAS __attribute__((address_space(3)))
DI int otid() { int t = threadIdx.x; asm volatile("" : "+v"(t)); return t; }

constexpr int MROWS = 18432, MLAT = 16384, DM = 1024, FFN = 2816, FH = 1408;
constexpr size_t MiB = 1u << 20;
constexpr size_t WS_X = 0, WS_W = 72 * MiB, WS_H = 97 * MiB, WS_QKV = 133 * MiB, WS_U = 133 * MiB, WS_ACT = 241 * MiB,
                 WS_ATT = 250 * MiB, WS_HF = 286 * MiB, WS_HB = WS_H, WS_G = 322 * MiB, WS_MOD = 340 * MiB, WS_ROPE = 341 * MiB, WS_BAR = 342 * MiB, WS_SSQ = 343 * MiB, WS_SB = 344 * MiB, WS_HG = 349 * MiB;
constexpr int UP_T0 = 12;
constexpr int SB_IN_LD = 3328, SB_UP_LD = 5632;
constexpr size_t SB_LAYER = (size_t)9 * (SB_IN_LD + SB_UP_LD);
constexpr size_t ZERO_BYTES = 4 * MiB;
constexpr size_t WOFF_IN = 0, WOFF_OUT = 13 * MiB / 2, WOFF_UP = 17 * MiB / 2, WOFF_DOWN = 39 * MiB / 2;
constexpr int LDS_BYTES = 151552;
constexpr int NPHASE = 46;

struct Args { const float* in[58]; float* out; unsigned char* ws; int ph_lo, ph_hi, use_sync, pad; };

DI int lbase(int l) { return l == 0 ? 4 : l == 1 ? 19 : l == 2 ? 31 : 42; }
DI int off_wout(int k) { return k == 0 ? 9 : k == 1 ? 6 : 5; }
DI int nin_of(int k) { return k == 0 ? 3072 : k == 1 ? 3104 : 1536; }
DI int ninpad_of(int k) { return k == 0 ? 3072 : k == 1 ? 3328 : 1536; }

DI unsigned pk2(float lo, float hi) { f32x2 v = {lo, hi}; bf16x2_t b = __builtin_convertvector(v, bf16x2_t); return __builtin_bit_cast(unsigned, b); }
DI float bflo(unsigned u) { return __uint_as_float(u << 16); }
DI float bfhi(unsigned u) { return __uint_as_float(u & 0xffff0000u); }
DI f32x16 mfma32(bf16x8 a, bf16x8 b, f32x16 c) { return __builtin_amdgcn_mfma_f32_32x32x16_bf16(a, b, c, 0, 0, 0); }
DI int crow(int i, int h) { return (i & 3) + 8 * (i >> 2) + 4 * h; }
DI float fexp2(float x) { return __builtin_amdgcn_exp2f(x); }
DI float wave_sum(float v) {
#pragma unroll
    for (int d = 32; d >= 1; d >>= 1) v += __shfl_xor(v, d);
    return v;
}
DI f32x16 zero16() { f32x16 z;
#pragma unroll
    for (int i = 0; i < 16; ++i) z[i] = 0.f; return z; }
DI bf16x8 pack8(const f32x16& x, int s) {
    u32x4 p; p[0] = pk2(x[8 * s], x[8 * s + 1]); p[1] = pk2(x[8 * s + 2], x[8 * s + 3]); p[2] = pk2(x[8 * s + 4], x[8 * s + 5]); p[3] = pk2(x[8 * s + 6], x[8 * s + 7]);
    return __builtin_bit_cast(bf16x8, p);
}

struct Epi {
    static constexpr bool PERM = false, AFTER_DRAIN = false;
    int mode;
    bf16_t* O; int ldo; int ropelim;
    const float* ropec; const float* ropes;
    float* G; const float* gate_b;
    float* X; const float* res_lat; const float* res_ctx; const float* gate;
    const float* ssq_in; const float* sbias;
    int sb_ld;
    bf16_t* Hout; const float* hgain; float* ssq_out;
    const float* cw; const float* cb; bf16_t* ACT; float* EDGE;
    __device__ __forceinline__ void operator()(const f32x4 (&acc)[2][2][4][2], const pg8::Unit& u, int wr, int wc, int fr, int fq) const {
        const int row0 = u.pm * 256 + wr * 64 + fr, col0 = u.pn * 256 + wc * 32 + 4 * fq;
#ifdef EPI_ONLY
        if (EPI_ONLY == 2) {
#else
        if (mode == 2) {
#endif
            const int ub = u.pm < 64 ? (u.pm >> 3) : 8;
            const float* gp = gate + (size_t)ub * 6144;
            f32x4 gv[2][2], hg[2][2];
#pragma unroll
            for (int bj = 0; bj < 2; ++bj)
#pragma unroll
                for (int n = 0; n < 2; ++n) {
                    const int c = col0 + bj * 128 + n * 16;
                    gv[bj][n] = *(const f32x4*)(gp + c);
                    hg[bj][n] = *(const f32x4*)(hgain + (size_t)ub * 1024 + c);
                }
#pragma unroll
            for (int ai = 0; ai < 2; ++ai)
#pragma unroll
                for (int mp = 0; mp < 2; ++mp) {
                    f32x4 rv[2][2][2];
#pragma unroll
                    for (int mm = 0; mm < 2; ++mm) {
                        const int r = row0 + ai * 128 + (2 * mp + mm) * 16;
                        const float* rp = r < MLAT ? res_lat + (size_t)r * DM : res_ctx + (size_t)(r - MLAT) * DM;
#pragma unroll
                        for (int bj = 0; bj < 2; ++bj)
#pragma unroll
                            for (int n = 0; n < 2; ++n) rv[mm][bj][n] = *(const f32x4*)(rp + col0 + bj * 128 + n * 16);
                    }
#pragma unroll
                    for (int mm = 0; mm < 2; ++mm) {
                        const int m = 2 * mp + mm, r = row0 + ai * 128 + m * 16;
                        float* xp = X + (size_t)r * DM;
                        float ss = 0.f;
#pragma unroll
                        for (int bj = 0; bj < 2; ++bj)
#pragma unroll
                            for (int n = 0; n < 2; ++n) {
                                const int c = col0 + bj * 128 + n * 16;
                                const f32x4 xn = rv[mm][bj][n] + gv[bj][n] * acc[ai][bj][m][n];
                                *(f32x4*)(xp + c) = xn;
                                if (Hout) {
                                    ss += xn[0] * xn[0] + xn[1] * xn[1] + xn[2] * xn[2] + xn[3] * xn[3];
                                    const f32x4 hv = xn * hg[bj][n];
                                    u32x2 p; p[0] = pk2(hv[0], hv[1]); p[1] = pk2(hv[2], hv[3]);
                                    *(u32x2*)(Hout + (size_t)r * DM + c) = p;
                                }
                            }
                        if (Hout) {
                            ss += __shfl_xor(ss, 16); ss += __shfl_xor(ss, 32);
                            if (fq == 0) atomicAdd(ssq_out + r, ss);
                        }
                    }
                }
#ifdef EPI_ONLY
        } else if (EPI_ONLY == 1) {
#else
        } else if (mode == 1) {
#endif
            const float sc = u.pn < 2 ? 0.125f : 1.0f;
            const f32x4 gbv[2] = {*(const f32x4*)(gate_b + 4 * fq), *(const f32x4*)(gate_b + 16 + 4 * fq)};
            const int ub = u.pm < 64 ? (u.pm >> 3) : 8;
            f32x4 sbv[2][2];
#pragma unroll
            for (int bj = 0; bj < 2; ++bj)
#pragma unroll
                for (int n = 0; n < 2; ++n) sbv[bj][n] = *(const f32x4*)(sbias + (size_t)ub * sb_ld + col0 + bj * 128 + n * 16);
            float rsv[2][4];
#pragma unroll
            for (int ai = 0; ai < 2; ++ai)
#pragma unroll
                for (int m = 0; m < 4; ++m) rsv[ai][m] = rsqrtf(ssq_in[row0 + ai * 128 + m * 16] * (1.0f / 1024.0f) + 1e-6f);
#pragma unroll
            for (int ai = 0; ai < 2; ++ai)
#pragma unroll
                for (int m = 0; m < 4; ++m) {
                    const int r = row0 + ai * 128 + m * 16;
                    const float rs = rsv[ai][m];
                    if (u.pn == 12) {
                        if (wc == 0) {
#pragma unroll
                            for (int n = 0; n < 2; ++n) {
                                const int lc = n * 16 + 4 * fq;
                                *(f32x4*)(G + (size_t)r * 32 + lc) = acc[ai][0][m][n] * rs + sbv[0][n] + gbv[n];
                            }
                        }
                    } else {
                        bf16_t* op = O + (size_t)r * ldo;
#pragma unroll
                        for (int bj = 0; bj < 2; ++bj)
#pragma unroll
                            for (int n = 0; n < 2; ++n) {
                                const f32x4 v = (acc[ai][bj][m][n] * rs + sbv[bj][n]) * sc;
                                u32x2 p; p[0] = pk2(v[0], v[1]); p[1] = pk2(v[2], v[3]);
                                *(u32x2*)(op + col0 + bj * 128 + n * 16) = p;
                            }
                    }
                }
        } else if (mode == 4) {
            const int ub = u.pm < 64 ? (u.pm >> 3) : 8;
            const int ch0 = u.pn * 128 + wc * 32 + 4 * fq;
            const __amdgpu_buffer_rsrc_t ersrc = __builtin_amdgcn_make_buffer_rsrc((void*)EDGE, 0, 288 * 4 * 2 * FFN * 4, 0x00020000);
            LAS float* cst = (LAS float*)(unsigned)(131072 + 1024 + (wr * 4 + wc) * 1280);
            {
                const int ln = fr + 16 * fq, hv = ln >> 5, c = ln & 31;
                const float* cwp = cw + u.pn * 128 + wc * 32; const float* cbp = cb + u.pn * 128 + wc * 32; const float* sbp = sbias + (size_t)ub * sb_ld + u.pn * 256 + wc * 32;
                const float v01 = cwp[hv * 2 * FFN + c];
                const float v23 = cwp[(hv ? FFN : 2 * 2 * FFN) + c];
                const float v45 = cwp[(hv ? 2 * 2 * FFN + FFN : 2 * FFN + FFN) + c];
                const float v67 = cbp[hv * FFN + c];
                const float v89 = sbp[hv * 128 + c];
                cst[ln] = v01; cst[64 + ln] = v23; cst[128 + ln] = v45; cst[192 + ln] = v67; cst[256 + ln] = v89;
            }
            float rsa[2][4];
#pragma unroll
            for (int ai = 0; ai < 2; ++ai)
#pragma unroll
                for (int m = 0; m < 4; ++m) rsa[ai][m] = rsqrtf(ssq_in[row0 + ai * 128 + m * 16] * (1.0f / 1024.0f) + 1e-6f);
#pragma unroll
            for (int n = 0; n < 2; ++n)
#pragma unroll
                for (int jp = 0; jp < 2; ++jp) {
                    __builtin_amdgcn_sched_barrier(0);
                    const int ch = ch0 + 16 * n + 2 * jp;
                    const int lc = 16 * n + 4 * fq + 2 * jp;
                    f32x2 wa[3], wg[3];
#pragma unroll
                    for (int j = 0; j < 3; ++j) { wa[j] = *(const LAS f32x2*)(cst + j * 32 + lc); wg[j] = *(const LAS f32x2*)(cst + (3 + j) * 32 + lc); }
                    const f32x2 ba = *(const LAS f32x2*)(cst + 6 * 32 + lc), bg = *(const LAS f32x2*)(cst + 7 * 32 + lc);
                    const f32x2 sa = *(const LAS f32x2*)(cst + 8 * 32 + lc), sg = *(const LAS f32x2*)(cst + 9 * 32 + lc);
#pragma unroll
                    for (int ai = 0; ai < 2; ++ai) {
                        const int seg = (row0 + ai * 128) >> 6;
                        const unsigned eo0 = fr < 2 ? (unsigned)(((seg * 4 + fr) * 2 * FFN + ch) * 4) : 0xf0000000u, eo3 = fr >= 14 ? (unsigned)(((seg * 4 + fr - 12) * 2 * FFN + ch) * 4) : 0xf0000000u;
                        float y[4][2], e0[4];
#pragma unroll
                        for (int jj = 0; jj < 2; ++jj) {
                            const int j = 2 * jp + jj;
                            float xa[4], xg[4];
#pragma unroll
                            for (int m = 0; m < 4; ++m) { xa[m] = acc[ai][0][m][n][j] * rsa[ai][m] + sa[jj]; xg[m] = acc[ai][1][m][n][j] * rsa[ai][m] + sg[jj]; }
#pragma unroll
                            for (int m = 0; m < 4; ++m) {
                                const int oa = m > 0 ? __builtin_amdgcn_mov_dpp(__builtin_bit_cast(int, xa[m > 0 ? m - 1 : 0]), 0x121, 0xf, 0xf, false) : 0;
                                const int og = m > 0 ? __builtin_amdgcn_mov_dpp(__builtin_bit_cast(int, xg[m > 0 ? m - 1 : 0]), 0x121, 0xf, 0xf, false) : 0;
                                const float pa = __builtin_bit_cast(float, __builtin_amdgcn_update_dpp(oa, __builtin_bit_cast(int, xa[m]), 0x111, 0xf, 0xf, false));
                                const float pg = __builtin_bit_cast(float, __builtin_amdgcn_update_dpp(og, __builtin_bit_cast(int, xg[m]), 0x111, 0xf, 0xf, false));
                                const int qa = m < 3 ? __builtin_amdgcn_mov_dpp(__builtin_bit_cast(int, xa[m < 3 ? m + 1 : 3]), 0x12f, 0xf, 0xf, false) : 0;
                                const int qg = m < 3 ? __builtin_amdgcn_mov_dpp(__builtin_bit_cast(int, xg[m < 3 ? m + 1 : 3]), 0x12f, 0xf, 0xf, false) : 0;
                                const float na = __builtin_bit_cast(float, __builtin_amdgcn_update_dpp(qa, __builtin_bit_cast(int, xa[m]), 0x101, 0xf, 0xf, false));
                                const float ng = __builtin_bit_cast(float, __builtin_amdgcn_update_dpp(qg, __builtin_bit_cast(int, xg[m]), 0x101, 0xf, 0xf, false));
                                const float av = ba[jj] + wa[0][jj] * pa + wa[1][jj] * xa[m] + wa[2][jj] * na;
                                const float gv = bg[jj] + wg[0][jj] * pg + wg[1][jj] * xg[m] + wg[2][jj] * ng;
                                y[m][jj] = av * gv * __builtin_amdgcn_rcpf(1.f + __expf(-gv));
                            }
                            if (jj == 0) { e0[0] = xa[0]; e0[1] = xg[0]; e0[2] = xa[3]; e0[3] = xg[3]; }
                            else {
                                u32x2 v;
                                v[0] = __builtin_bit_cast(unsigned, e0[0]); v[1] = __builtin_bit_cast(unsigned, xa[0]); __builtin_amdgcn_raw_buffer_store_b64(v, ersrc, (int)eo0, 0, 0);
                                v[0] = __builtin_bit_cast(unsigned, e0[1]); v[1] = __builtin_bit_cast(unsigned, xg[0]); __builtin_amdgcn_raw_buffer_store_b64(v, ersrc, (int)(eo0 + FFN * 4), 0, 0);
                                v[0] = __builtin_bit_cast(unsigned, e0[2]); v[1] = __builtin_bit_cast(unsigned, xa[3]); __builtin_amdgcn_raw_buffer_store_b64(v, ersrc, (int)eo3, 0, 0);
                                v[0] = __builtin_bit_cast(unsigned, e0[3]); v[1] = __builtin_bit_cast(unsigned, xg[3]); __builtin_amdgcn_raw_buffer_store_b64(v, ersrc, (int)(eo3 + FFN * 4), 0, 0);
                            }
                        }
#pragma unroll
                        for (int m = 0; m < 4; ++m) {
                            const int r = row0 + ai * 128 + m * 16;
                            *(unsigned*)(ACT + (size_t)r * FFN + ch) = pk2(y[m][0], y[m][1]);
                        }
                    }
                }
        } else if (mode == 3) {
#pragma unroll
            for (int ai = 0; ai < 2; ++ai)
#pragma unroll
                for (int m = 0; m < 4; ++m) {
                    bf16_t* op = O + (size_t)(row0 + ai * 128 + m * 16) * ldo;
#pragma unroll
                    for (int bj = 0; bj < 2; ++bj)
#pragma unroll
                        for (int n = 0; n < 2; ++n) {
                            const f32x4 v = acc[ai][bj][m][n];
                            u32x2 p; p[0] = pk2(v[0], v[1]); p[1] = pk2(v[2], v[3]);
                            *(u32x2*)(op + col0 + bj * 128 + n * 16) = p;
                        }
                }
        } else {
            const bool tile_rope = (u.pn * 256) < ropelim;
            const LAS float* ropeL = (const LAS float*)(unsigned)(131072 + 1024 + 10240);
            const int ub = u.pm < 64 ? (u.pm >> 3) : 8;
            f32x4 sbv[2][2];
#pragma unroll
            for (int bj = 0; bj < 2; ++bj)
#pragma unroll
                for (int n = 0; n < 2; ++n) sbv[bj][n] = *(const f32x4*)(sbias + (size_t)ub * sb_ld + col0 + bj * 128 + n * 16);
            float rsv[2][4];
#pragma unroll
            for (int ai = 0; ai < 2; ++ai)
#pragma unroll
                for (int m = 0; m < 4; ++m) rsv[ai][m] = rsqrtf(ssq_in[row0 + ai * 128 + m * 16] * (1.0f / 1024.0f) + 1e-6f);
#pragma unroll
            for (int ai = 0; ai < 2; ++ai)
#pragma unroll
                for (int m = 0; m < 4; ++m) {
                    const int r = row0 + ai * 128 + m * 16;
                    const float rs = rsv[ai][m];
                    bf16_t* op = O + (size_t)r * ldo;
                    if (tile_rope && r < MLAT) {
                        const int s = r & 2047, pos = (wc & 1) ? (s & 63) : (s >> 6);
                        const f32x4 cs = *(const LAS f32x4*)(ropeL + pos * 16 + 4 * fq), sn = *(const LAS f32x4*)(ropeL + 1024 + pos * 16 + 4 * fq);
#pragma unroll
                        for (int bj = 0; bj < 2; ++bj) {
                            const f32x4 x1 = acc[ai][bj][m][0] * rs + sbv[bj][0], x2 = acc[ai][bj][m][1] * rs + sbv[bj][1];
                            const f32x4 y1 = x1 * cs - x2 * sn, y2 = x2 * cs + x1 * sn;
                            u32x2 p; p[0] = pk2(y1[0], y1[1]); p[1] = pk2(y1[2], y1[3]);
                            *(u32x2*)(op + col0 + bj * 128) = p;
                            p[0] = pk2(y2[0], y2[1]); p[1] = pk2(y2[2], y2[3]);
                            *(u32x2*)(op + col0 + bj * 128 + 16) = p;
                        }
                    } else {
#pragma unroll
                        for (int bj = 0; bj < 2; ++bj)
#pragma unroll
                            for (int n = 0; n < 2; ++n) {
                                const f32x4 v = acc[ai][bj][m][n] * rs + sbv[bj][n];
                                u32x2 p; p[0] = pk2(v[0], v[1]); p[1] = pk2(v[2], v[3]);
                                *(u32x2*)(op + col0 + bj * 128 + n * 16) = p;
                            }
                    }
                }
        }
    }
};

DI void run_gemm(char* shm, const bf16_t* A, const bf16_t* Bt, int M, int N, int K, const Epi& E) {
    pg8::Gemm g; g.A = A; g.Bt = Bt; g.M = M; g.N = N; g.K = K;
    pg8::StaticOrder S; S.init(M, N, (int)gridDim.x, (int)blockIdx.x);
#ifndef NO_GEMM
    pg8::gemm_phase<Epi, pg8::StaticOrder>((LAS unsigned char*)shm, g, S, E);
#endif
    __syncthreads();
}

DI void phase_prologue(const Args& a, char* shm) {
    float* sc = (float*)shm;
    float* red = sc + 9 * 1024;
    const int tid = otid();
    for (int i = tid; i < 9 * 1024; i += 512) { const int r = i >> 10, k = i & 1023; const float v = r < 8 ? a.in[1][r * 1024 + k] : a.in[3][k]; sc[i] = v / (1.f + __expf(-v)); }
    __syncthreads();
    float* mod = (float*)(a.ws + WS_MOD);
    for (int item = blockIdx.x; item < 193; item += gridDim.x) {
        if (item < 192) {
            const int l = item / 48, j0 = (item % 48) * 128, col = tid & 127, kq = tid >> 7;
            const float* W = a.in[lbase(l)] + j0 + col;
            float acc[9];
#pragma unroll
            for (int r = 0; r < 9; ++r) acc[r] = 0.f;
            for (int k = kq * 256; k < kq * 256 + 256; k += 32) {
                float w[32];
#pragma unroll
                for (int j = 0; j < 32; ++j) w[j] = __builtin_nontemporal_load(W + (size_t)(k + j) * 6144);
#pragma unroll
                for (int j = 0; j < 32; j += 4)
#pragma unroll
                    for (int r = 0; r < 9; ++r) { const f32x4 s = *(const f32x4*)(sc + r * 1024 + k + j); acc[r] += s[0] * w[j] + s[1] * w[j + 1] + s[2] * w[j + 2] + s[3] * w[j + 3]; }
            }
#pragma unroll
            for (int r = 0; r < 9; ++r) red[(kq * 9 + r) * 128 + col] = acc[r];
            __syncthreads();
            for (int i = tid; i < 9 * 128; i += 512) {
                const int r = i >> 7, cc = i & 127;
                const float s = red[r * 128 + cc] + red[(9 + r) * 128 + cc] + red[(18 + r) * 128 + cc] + red[(27 + r) * 128 + cc];
                mod[(size_t)(l * 9 + r) * 6144 + j0 + cc] = s + a.in[lbase(l) + 1][j0 + cc];
            }
            __syncthreads();
        } else {
            float* ropec = (float*)(a.ws + WS_ROPE); float* ropes = ropec + 1024; float* lam = ropec + 2048;
            for (int i = tid; i < 1024; i += 512) {
                const int pos = i >> 4, f = i & 15;
                const float inv = powf(10000.0f, -(float)f / 16.0f), ang = (float)pos * inv;
                ropec[i] = cosf(ang); ropes[i] = sinf(ang);
            }
            if (tid < 2) {
                const int l = tid == 0 ? 0 : 3, bs = lbase(l);
                float s1 = 0.f, s2 = 0.f;
                for (int k = 0; k < 64; ++k) { s1 += a.in[bs + 4][k] * a.in[bs + 5][k]; s2 += a.in[bs + 6][k] * a.in[bs + 7][k]; }
                const float lam_init = 0.8f - 0.6f * expf(-0.3f * (float)l);
                lam[tid * 2] = expf(s1) - expf(s2) + lam_init; lam[tid * 2 + 1] = lam_init;
            }
        }
    }
}

DI void convert_st(const float* W, int K, int N, bf16_t* Wt, int kt, int nt4, int upperm, float* T, float* sh, const float* shift, float* sb, int sb_ld) {
    const int tid = otid(), k0 = kt * 64, n0 = nt4 * 256;
    __syncthreads();
#pragma unroll
    for (int it = 0; it < 8; ++it) {
        const int k = it * 8 + (tid >> 6), n4 = (tid & 63) * 4;
        f32x4 v = {0.f, 0.f, 0.f, 0.f};
        if (n0 + n4 < N) v = *(const f32x4*)(W + (size_t)(k0 + k) * N + n0 + n4);
        *(f32x4*)(T + k * 260 + n4) = v;
    }
    if (sb) { for (int i = tid; i < 576; i += 512) sh[i] = shift[(size_t)(i >> 6) * 6144 + k0 + (i & 63)]; }
    __syncthreads();
    const int n = tid >> 1, kh = tid & 1, nn = n0 + n;
    int row = nn;
    if (upperm) { const int f = nn < FFN ? nn : nn - FFN; row = 256 * (f >> 7) + (nn < FFN ? 0 : 128) + (f & 127); }
    float v[32];
#pragma unroll
    for (int i = 0; i < 32; ++i) v[i] = T[(32 * kh + i) * 260 + n];
    bf16_t* dst = Wt + (size_t)row * K + k0 + 32 * kh;
#pragma unroll
    for (int j = 0; j < 4; ++j) {
        u32x4 p; p[0] = pk2(v[8 * j], v[8 * j + 1]); p[1] = pk2(v[8 * j + 2], v[8 * j + 3]); p[2] = pk2(v[8 * j + 4], v[8 * j + 5]); p[3] = pk2(v[8 * j + 6], v[8 * j + 7]);
        *(u32x4*)(dst + 8 * j) = p;
    }
    if (sb) {
#pragma unroll
        for (int rb = 0; rb < 9; ++rb) {
            float p = 0.f;
#pragma unroll
            for (int i = 0; i < 32; i += 4) { const f32x4 s4 = *(const f32x4*)(sh + rb * 64 + 32 * kh + i); p += s4[0] * v[i] + s4[1] * v[i + 1] + s4[2] * v[i + 2] + s4[3] * v[i + 3]; }
            p += __shfl_xor(p, 1);
            if (kh == 0 && nn < N) atomicAdd(sb + (size_t)rb * sb_ld + row, p);
        }
    }
}
DI void phase_convert(const Args& a, char* shm, int l, int which, int idx, int nstride) {
    const int kind = l % 3, bs = lbase(l), nin = nin_of(kind), nint = (nin + 255) >> 8;
    const int n_in = (which & 1) ? nint * 16 : 0, n_out = (which & 2) ? 64 : 0, n_up = (which & 4) ? 22 * 16 : 0, n_down = (which & 8) ? 4 * 44 : 0;
    const int total = n_in + n_out + n_up + n_down;
    unsigned char* wb = a.ws + WS_W;
    float* T = (float*)shm; float* sh = T + 64 * 260;
    const float* mod_l = (const float*)(a.ws + WS_MOD) + (size_t)l * 9 * 6144;
    float* sb_in = (float*)(a.ws + WS_SB) + (size_t)l * SB_LAYER; float* sb_up = sb_in + 9 * SB_IN_LD;
    for (int item = idx; item < total; item += nstride) {
        int it = item;
        if (it < n_in) { convert_st(a.in[bs + 3], 1024, nin, (bf16_t*)(wb + WOFF_IN), it & 15, it >> 4, 0, T, sh, mod_l, sb_in, SB_IN_LD); continue; }
        it -= n_in;
        if (it < n_out) { convert_st(a.in[bs + off_wout(kind)], 1024, 1024, (bf16_t*)(wb + WOFF_OUT), it & 15, it >> 4, 0, T, sh, nullptr, nullptr, 0); continue; }
        it -= n_out;
        if (it < n_up) { convert_st(a.in[bs + off_wout(kind) + 2], 1024, 2 * FFN, (bf16_t*)(wb + WOFF_UP), it & 15, it >> 4, 1, T, sh, mod_l + 3072, sb_up, SB_UP_LD); continue; }
        it -= n_up;
        convert_st(a.in[bs + off_wout(kind) + 5], FFN, 1024, (bf16_t*)(wb + WOFF_DOWN), it % 44, it / 44, 0, T, sh, nullptr, nullptr, 0);
    }
    __syncthreads();
}

DI void phase_prenorm(const float* Xl, const float* Xc, const float* g, const float* mod_l, int scoff, bf16_t* H, float* ssq, int nrows) {
    const int lane = otid() & 63, wid = otid() >> 6, rstride = gridDim.x * 8;
    for (int row0 = blockIdx.x * 8 + wid; row0 < nrows; row0 += 4 * rstride) {
        f32x4 v[4][4];
#pragma unroll
        for (int k = 0; k < 4; ++k) {
            const int rk = row0 + k * rstride, row = rk < nrows ? rk : row0;
            const float* xr = row < MLAT ? Xl + (size_t)row * DM : Xc + (size_t)(row - MLAT) * DM;
#pragma unroll
            for (int i = 0; i < 4; ++i) v[k][i] = *(const f32x4*)(xr + i * 256 + lane * 4);
        }
#pragma unroll
        for (int k = 0; k < 4; ++k) {
            const int row = row0 + k * rstride;
            if (row < nrows) {
                const float* mp = mod_l + (size_t)(row < MLAT ? (row >> 11) : 8) * 6144;
                float ss = 0.f;
#pragma unroll
                for (int i = 0; i < 4; ++i) ss += v[k][i][0] * v[k][i][0] + v[k][i][1] * v[k][i][1] + v[k][i][2] * v[k][i][2] + v[k][i][3] * v[k][i][3];
                ss = wave_sum(ss);
                if (lane == 0) ssq[row] = ss;
#pragma unroll
                for (int i = 0; i < 4; ++i) {
                    const int c = i * 256 + lane * 4;
                    const f32x4 gg = *(const f32x4*)(g + c), sc = *(const f32x4*)(mp + scoff + c);
                    const f32x4 y = (v[k][i] * gg) * (sc + 1.0f);
                    u32x2 p; p[0] = pk2(y[0], y[1]); p[1] = pk2(y[2], y[3]);
                    *(u32x2*)(H + (size_t)row * DM + c) = p;
                }
            }
        }
    }
}
DI void phase_final_norm(const float* X, const float* g, float* out) {
    const int lane = otid() & 63, wid = otid() >> 6, rstride = gridDim.x * 8;
    f32x4 gg[4];
#pragma unroll
    for (int i = 0; i < 4; ++i) gg[i] = *(const f32x4*)(g + i * 256 + lane * 4);
    for (int row0 = blockIdx.x * 8 + wid; row0 < MLAT; row0 += 4 * rstride) {
        f32x4 v[4][4];
#pragma unroll
        for (int k = 0; k < 4; ++k) {
            const int rk = row0 + k * rstride, row = rk < MLAT ? rk : row0;
#pragma unroll
            for (int i = 0; i < 4; ++i) v[k][i] = *(const f32x4*)(X + (size_t)row * DM + i * 256 + lane * 4);
        }
#pragma unroll
        for (int k = 0; k < 4; ++k) {
            const int row = row0 + k * rstride;
            if (row < MLAT) {
                float ss = 0.f;
#pragma unroll
                for (int i = 0; i < 4; ++i) ss += v[k][i][0] * v[k][i][0] + v[k][i][1] * v[k][i][1] + v[k][i][2] * v[k][i][2] + v[k][i][3] * v[k][i][3];
                ss = wave_sum(ss);
                const float rstd = rsqrtf(ss * (1.0f / 1024.0f) + 1e-6f);
#pragma unroll
                for (int i = 0; i < 4; ++i) *(f32x4*)(out + (size_t)row * DM + i * 256 + lane * 4) = v[k][i] * rstd * gg[i];
            }
        }
    }
}

struct AttnP { const bf16_t* QKV; int pitch, qrow, qcol, kcol0, kslot, vcol, ntile, ctxrow0, latrow0, qpos, kpos0; };
constexpr float C2 = 0.125f * 1.4426950408889634f;

template <int NKT, int NDVB, bool SWA>
DI void attn_core(char* shm, const AttnP& P, f32x16 (&O)[NDVB], float& mrow, float& lrow) {
    constexpr int KB = 64 * 144, VB = 32 * NDVB * 144, STAGE = NKT * KB + VB, NVL = NDVB / 2;
    const int tid = otid(), lane = tid & 63, l31 = lane & 31, hh = lane >> 5;
    bf16x8 qf[4];
#pragma unroll
    for (int ks = 0; ks < 4; ++ks) qf[ks] = *(const bf16x8*)(P.QKV + (size_t)(P.qrow + l31) * P.pitch + P.qcol + ks * 16 + hh * 8);
    mrow = -1e30f; lrow = 0.f;
#pragma unroll
    for (int d = 0; d < NDVB; ++d) O[d] = zero16();
    const int kkey = tid >> 3, kch = tid & 7, vkey = tid & 63, vch0 = tid >> 6;
    const int vpos = (vkey & ~12) | ((vkey & 4) << 1) | ((vkey & 8) >> 1);
    u32x4 kreg[NKT], vreg[NVL];
#define ATT_GLOAD(t) do { const int r0_ = (t) < 4 ? P.ctxrow0 + 64 * (t) : P.latrow0 + 64 * ((t) - 4); \
        _Pragma("unroll") for (int c = 0; c < NKT; ++c) kreg[c] = *(const u32x4*)(P.QKV + (size_t)(r0_ + kkey) * P.pitch + P.kcol0 + c * 64 + kch * 8); \
        _Pragma("unroll") for (int j = 0; j < NVL; ++j) vreg[j] = *(const u32x4*)(P.QKV + (size_t)(r0_ + vkey) * P.pitch + P.vcol + (vch0 + 8 * j) * 8); } while (0)
    ATT_GLOAD(0);
    for (int t = 0; t < P.ntile; ++t) {
        char* base = shm + (t & 1) * STAGE;
#pragma unroll
        for (int c = 0; c < NKT; ++c) *(u32x4*)(base + c * KB + kkey * 144 + kch * 16) = kreg[c];
#pragma unroll
        for (int j = 0; j < NVL; ++j) {
            char* vb = base + NKT * KB + ((vch0 + 8 * j) * 8) * 144 + vpos * 2;
#pragma unroll
            for (int i = 0; i < 8; ++i) *(unsigned short*)(vb + i * 144) = (unsigned short)((vreg[j][i >> 1] >> (16 * (i & 1))) & 0xffffu);
        }
        __syncthreads();
        if (t + 1 < P.ntile) ATT_GLOAD(t + 1);
        const char* kbase = base + P.kslot * KB;
        f32x16 S[2]; S[0] = zero16(); S[1] = zero16();
        {
            bf16x8 kf[2][4];
#pragma unroll
            for (int kb = 0; kb < 2; ++kb)
#pragma unroll
                for (int ks = 0; ks < 4; ++ks) kf[kb][ks] = *(const bf16x8*)(kbase + (kb * 32 + l31) * 144 + (ks * 16 + hh * 8) * 2);
            __builtin_amdgcn_sched_barrier(0);
            __builtin_amdgcn_s_setprio(1);
#pragma unroll
            for (int ks = 0; ks < 4; ++ks)
#pragma unroll
                for (int kb = 0; kb < 2; ++kb) S[kb] = mfma32(kf[kb][ks], qf[ks], S[kb]);
            __builtin_amdgcn_s_setprio(0);
        }
        bool need_mask = false;
        if (SWA) { if (t >= 4) { const int k0 = P.kpos0 + 64 * (t - 4); need_mask = (P.qpos + 31 - k0 > 128) || (k0 + 63 - P.qpos > 128); } }
        float mx = -1e30f;
#pragma unroll
        for (int kb = 0; kb < 2; ++kb)
#pragma unroll
            for (int i = 0; i < 16; ++i) {
                if (SWA) { if (need_mask) { const int dd = (P.qpos + l31) - (P.kpos0 + 64 * (t - 4) + kb * 32 + crow(i, hh)); if (dd > 128 || dd < -128) S[kb][i] = -1e30f; } }
                mx = fmaxf(mx, S[kb][i]);
            }
        mx = fmaxf(mx, __shfl_xor(mx, 32));
        const float mnew = fmaxf(mrow, mx);
        const float mc = mnew * C2;
        float rs = 0.f;
#pragma unroll
        for (int kb = 0; kb < 2; ++kb)
#pragma unroll
            for (int i = 0; i < 16; ++i) { const float p = fexp2(__builtin_fmaf(S[kb][i], C2, -mc)); S[kb][i] = p; rs += p; }
        rs += __shfl_xor(rs, 32);
        if (__any(mnew != mrow)) {
            const float alpha = fexp2((mrow - mnew) * C2);
            lrow *= alpha;
#pragma unroll
            for (int d = 0; d < NDVB; ++d) O[d] = O[d] * alpha;
        }
        mrow = mnew;
        lrow += rs;
        {
            bf16x8 vf[2][2][NDVB];
#pragma unroll
            for (int kb = 0; kb < 2; ++kb)
#pragma unroll
                for (int s = 0; s < 2; ++s)
#pragma unroll
                    for (int d = 0; d < NDVB; ++d) vf[kb][s][d] = *(const bf16x8*)(base + NKT * KB + (d * 32 + l31) * 144 + (kb * 32 + s * 16 + hh * 8) * 2);
            bf16x8 pf[2][2];
#pragma unroll
            for (int kb = 0; kb < 2; ++kb) { pf[kb][0] = pack8(S[kb], 0); pf[kb][1] = pack8(S[kb], 1); }
            __builtin_amdgcn_sched_barrier(0);
            __builtin_amdgcn_s_setprio(1);
#pragma unroll
            for (int kb = 0; kb < 2; ++kb)
#pragma unroll
                for (int s = 0; s < 2; ++s)
#pragma unroll
                    for (int d = 0; d < NDVB; ++d) O[d] = mfma32(vf[kb][s][d], pf[kb][s], O[d]);
            __builtin_amdgcn_s_setprio(0);
        }
    }
#undef ATT_GLOAD
    __syncthreads();
}

DI void phase_da(const Args& a, char* shm, int l, bool need_ctx) {
    const bf16_t* QKV = (const bf16_t*)(a.ws + WS_QKV);
    bf16_t* ATT = (bf16_t*)(a.ws + WS_ATT);
    const float* lamp = (const float*)(a.ws + WS_ROPE) + 2048 + (l == 0 ? 0 : 2);
    const float lam = lamp[0], lam_init = lamp[1];
    const float* subg = a.in[lbase(l) + 8];
    const int lane = otid() & 63, wid = otid() >> 6, l31 = lane & 31, hh = lane >> 5;
    const int comp = wid >> 2, wq = wid & 3;
    float* xch = (float*)shm;
    const int nitem = 1024 + (need_ctx ? 128 : 0);
    for (int item = blockIdx.x; item < nitem; item += gridDim.x) {
        AttnP P; P.QKV = QKV; P.pitch = 3072; P.qpos = 0; P.kpos0 = 0;
        int b, h;
        if (item < 1024) {
            const int xcd = item & 7, j = item >> 3, qb = j & 15, bh = (j >> 4) * 8 + xcd;
            b = bh >> 3; h = bh & 7;
            P.qrow = b * 2048 + qb * 128 + wq * 32; P.ntile = 36;
        } else {
            const int i2 = item - 1024, qb = i2 & 1; h = (i2 >> 1) & 7; b = i2 >> 4;
            P.qrow = MLAT + b * 256 + qb * 128 + wq * 32; P.ntile = 4;
        }
        P.ctxrow0 = MLAT + b * 256; P.latrow0 = b * 2048;
        P.qcol = h * 128 + comp * 64; P.kcol0 = 1024 + h * 128; P.kslot = comp; P.vcol = 2048 + h * 128;
        f32x16 O[4]; float mr, lr;
        attn_core<2, 4, false>(shm, P, O, mr, lr);
        if (comp == 1) {
            const float inv1 = lam / lr;
#pragma unroll
            for (int d = 0; d < 4; ++d)
#pragma unroll
                for (int i = 0; i < 16; ++i) xch[((wq * 4 + d) * 16 + i) * 64 + lane] = O[d][i] * inv1;
        }
        __syncthreads();
        if (comp == 0) {
            const float inv0 = 1.0f / lr;
            float ss = 0.f;
#pragma unroll
            for (int d = 0; d < 4; ++d)
#pragma unroll
                for (int i = 0; i < 16; ++i) { const float o = O[d][i] * inv0 - xch[((wq * 4 + d) * 16 + i) * 64 + lane]; O[d][i] = o; ss += o * o; }
            ss += __shfl_xor(ss, 32);
            const float rstd = rsqrtf(ss * (1.0f / 128.0f) + 1e-6f) * (1.0f - lam_init);
            bf16_t* op = ATT + (size_t)(P.qrow + l31) * DM + h * 128;
#pragma unroll
            for (int d = 0; d < 4; ++d)
#pragma unroll
                for (int ig = 0; ig < 4; ++ig) {
                    const int dv = 32 * d + 8 * ig + 4 * hh;
                    const f32x4 g4 = *(const f32x4*)(subg + dv);
                    u32x2 p; p[0] = pk2(O[d][4 * ig] * rstd * g4[0], O[d][4 * ig + 1] * rstd * g4[1]);
                    p[1] = pk2(O[d][4 * ig + 2] * rstd * g4[2], O[d][4 * ig + 3] * rstd * g4[3]);
                    *(u32x2*)(op + dv) = p;
                }
        }
        __syncthreads();
    }
}

DI void phase_swa(const Args& a, char* shm, int l, bool need_ctx) {
    const bf16_t* QKV = (const bf16_t*)(a.ws + WS_QKV);
    bf16_t* ATT = (bf16_t*)(a.ws + WS_ATT);
    const float* sink = a.in[lbase(l) + 4];
    const int lane = otid() & 63, wid = otid() >> 6, l31 = lane & 31, hh = lane >> 5;
    const int nitem = 1024 + (need_ctx ? 128 : 0);
    for (int item = blockIdx.x; item < nitem; item += gridDim.x) {
        AttnP P; P.QKV = QKV; P.pitch = 1536; P.kslot = 0;
        int b, kvh;
        if (item < 1024) {
            const int qb = item & 31; kvh = (item >> 5) & 3; b = item >> 7;
            const int q0 = qb * 64, ks = q0 - 128 < 0 ? 0 : q0 - 128, ke = q0 + 192 > 2048 ? 2048 : q0 + 192;
            P.ntile = 4 + ((ke - ks) >> 6); P.latrow0 = b * 2048 + ks; P.kpos0 = ks;
            P.qpos = q0 + (wid & 1) * 32; P.qrow = b * 2048 + P.qpos;
        } else {
            const int i2 = item - 1024, j = i2 & 3; kvh = (i2 >> 2) & 3; b = i2 >> 4;
            P.ntile = 4; P.latrow0 = 0; P.kpos0 = 0; P.qpos = 0;
            P.qrow = MLAT + b * 256 + j * 64 + (wid & 1) * 32;
        }
        const int head = kvh * 4 + (wid >> 1);
        P.ctxrow0 = MLAT + b * 256;
        P.qcol = head * 64; P.kcol0 = 1024 + kvh * 64; P.vcol = 1280 + kvh * 64;
        f32x16 O[2]; float mr, lr;
        attn_core<1, 2, true>(shm, P, O, mr, lr);
        const float ltot = lr + fexp2(sink[head] * 1.4426950408889634f - mr * C2);
        const float inv = 1.0f / ltot;
        bf16_t* op = ATT + (size_t)(P.qrow + l31) * DM + head * 64;
#pragma unroll
        for (int d = 0; d < 2; ++d)
#pragma unroll
            for (int ig = 0; ig < 4; ++ig) {
                const int dv = 32 * d + 8 * ig + 4 * hh;
                u32x2 p; p[0] = pk2(O[d][4 * ig] * inv, O[d][4 * ig + 1] * inv); p[1] = pk2(O[d][4 * ig + 2] * inv, O[d][4 * ig + 3] * inv);
                *(u32x2*)(op + dv) = p;
            }
    }
}

DI int ml_row(int b, int dir, int p) { return p < 256 ? MLAT + b * 256 + (dir ? 255 - p : p) : b * 2048 + (dir ? 2047 - (p - 256) : (p - 256)); }

DI void phase_mlstm(const Args& a, char* shm) {
    const bf16_t* QKV = (const bf16_t*)(a.ws + WS_QKV);
    const float* G = (const float*)(a.ws + WS_G);
    constexpr int pitch = 3328;
    float* sA = (float*)shm; float* sB = sA + 2304; float* sM = sB + 2304; float* sN = sM + 2304;
    char* Qs = shm + 32768; char* Ks = Qs + 9216; char* KgT = Ks + 9216; char* Vt = KgT + 9216; char* Cs = Vt + 18432;
    const int tid = otid(), lane = tid & 63, wid = tid >> 6, l31 = lane & 31, hh = lane >> 5;
    const int eb = wid >> 1, tb = wid & 1;
    for (int item = blockIdx.x; item < 128; item += gridDim.x) {
        const int b = item >> 4, h = (item >> 1) & 7, dir = item & 1;
        bf16_t* HD = (bf16_t*)(a.ws + (dir ? WS_HB : WS_HF));
        __syncthreads();
        for (int p = tid; p < 2304; p += 512) {
            const int row = ml_row(b, dir, p);
            const float ig = G[(size_t)row * 32 + (2 * dir) * 8 + h], fg = G[(size_t)row * 32 + (2 * dir + 1) * 8 + h];
            sA[p] = ig; sB[p] = fminf(fg, 0.f) - log1pf(expf(-fabsf(fg)));
        }
        for (int i = tid; i < 128 * 72 / 2; i += 512) ((unsigned*)Cs)[i] = 0u;
        if (tid < 64) sN[tid] = 0.f;
        __syncthreads();
        if (wid == 0) {
            const int p0 = lane * 36;
            float s = 0.f;
            for (int i = 0; i < 36; ++i) s += sB[p0 + i];
            float incl = s;
#pragma unroll
            for (int d = 1; d < 64; d <<= 1) { const float t = __shfl_up(incl, d); if (lane >= d) incl += t; }
            float run = incl - s, mxl = -3.0e38f;
            for (int i = 0; i < 36; ++i) { run += sB[p0 + i]; const float aa = sA[p0 + i] - run; sA[p0 + i] = aa; sM[p0 + i] = run; mxl = fmaxf(mxl, aa); }
            float inclm = mxl;
#pragma unroll
            for (int d = 1; d < 64; d <<= 1) { const float t = __shfl_up(inclm, d); if (lane >= d) inclm = fmaxf(inclm, t); }
            float offm = __shfl_up(inclm, 1); if (lane == 0) offm = 0.f;
            float runm = fmaxf(offm, 0.f);
            for (int i = 0; i < 36; ++i) { runm = fmaxf(runm, sA[p0 + i]); sB[p0 + i] = runm; sM[p0 + i] += runm; }
        }
        f32x16 Cacc = zero16(); float nacc = 0.f;
        const int qs_ = tid >> 3, qch = tid & 7, ss_ = tid & 63, sch = tid >> 6;
        const int spos = (ss_ & ~12) | ((ss_ & 4) << 1) | ((ss_ & 8) >> 1);
        u32x4 qreg, kreg, vreg[2];
#define ML_GLOAD(c) do { const int rq_ = ml_row(b, dir, 64 * (c) + qs_), rs_ = ml_row(b, dir, 64 * (c) + ss_); \
        qreg = *(const u32x4*)(QKV + (size_t)rq_ * pitch + h * 64 + qch * 8); \
        kreg = *(const u32x4*)(QKV + (size_t)rs_ * pitch + 512 + h * 64 + sch * 8); \
        vreg[0] = *(const u32x4*)(QKV + (size_t)rs_ * pitch + 1024 + h * 128 + sch * 8); \
        vreg[1] = *(const u32x4*)(QKV + (size_t)rs_ * pitch + 1024 + h * 128 + (sch + 8) * 8); } while (0)
        ML_GLOAD(0);
        __syncthreads();
        for (int c = 0; c < 36; ++c) {
            const int p0 = 64 * c;
            const float Aprev = c ? sB[p0 - 1] : 0.f, Aend = sB[p0 + 63], decay = __expf(Aprev - Aend);
            *(u32x4*)(Qs + qs_ * 144 + qch * 16) = qreg;
            *(u32x4*)(Ks + ss_ * 144 + sch * 16) = kreg;
            {
                const float gs = __expf(sA[p0 + ss_] - Aend);
#pragma unroll
                for (int i = 0; i < 8; ++i) {
                    const unsigned w = kreg[i >> 1];
                    const float kv = (i & 1) ? bfhi(w) : bflo(w);
                    *(unsigned short*)(KgT + (sch * 8 + i) * 144 + spos * 2) = (unsigned short)(pk2(kv * gs, 0.f) & 0xffffu);
                }
#pragma unroll
                for (int j = 0; j < 2; ++j)
#pragma unroll
                    for (int i = 0; i < 8; ++i)
                        *(unsigned short*)(Vt + ((sch + 8 * j) * 8 + i) * 144 + spos * 2) = (unsigned short)((vreg[j][i >> 1] >> (16 * (i & 1))) & 0xffffu);
            }
            __syncthreads();
            if (c + 1 < 36) ML_GLOAD(c + 1);
            const int t = 32 * tb + l31;
            const float At = sB[p0 + t], inter = __expf(Aprev - At);
            bf16x8 qf[4];
#pragma unroll
            for (int ks = 0; ks < 4; ++ks) qf[ks] = *(const bf16x8*)(Qs + t * 144 + (ks * 16 + hh * 8) * 2);
            f32x16 S[2]; S[0] = zero16(); S[1] = zero16();
#pragma unroll
            for (int sb = 0; sb < 2; ++sb)
                if (sb <= tb) {
#pragma unroll
                    for (int ks = 0; ks < 4; ++ks) { const bf16x8 af = *(const bf16x8*)(Ks + (sb * 32 + l31) * 144 + (ks * 16 + hh * 8) * 2); S[sb] = mfma32(af, qf[ks], S[sb]); }
                }
            float colsum = 0.f;
#pragma unroll
            for (int sb = 0; sb < 2; ++sb)
                if (sb <= tb) {
#pragma unroll
                    for (int iq = 0; iq < 4; ++iq) {
                        const int s0 = 32 * sb + 8 * iq + 4 * hh;
                        const f32x4 a4 = *(const f32x4*)(sA + p0 + s0);
#pragma unroll
                        for (int j = 0; j < 4; ++j) {
                            const float w = (s0 + j <= t) ? __expf(a4[j] - At) : 0.f;
                            const float pv = S[sb][4 * iq + j] * w; S[sb][4 * iq + j] = pv; colsum += pv;
                        }
                    }
                }
            colsum += __shfl_xor(colsum, 32);
            float qn = 0.f;
#pragma unroll
            for (int j = 0; j < 4; ++j) {
                const u32x4 q8 = *(const u32x4*)(Qs + t * 144 + (32 * hh + 8 * j) * 2);
                const f32x4 n0 = *(const f32x4*)(sN + 32 * hh + 8 * j), n1 = *(const f32x4*)(sN + 32 * hh + 8 * j + 4);
                qn += bflo(q8[0]) * n0[0] + bfhi(q8[0]) * n0[1] + bflo(q8[1]) * n0[2] + bfhi(q8[1]) * n0[3] + bflo(q8[2]) * n1[0] + bfhi(q8[2]) * n1[1] + bflo(q8[3]) * n1[2] + bfhi(q8[3]) * n1[3];
            }
            qn += __shfl_xor(qn, 32);
            const float den = inter * qn + colsum, mt = sM[p0 + t];
            const float rinv = 1.0f / fmaxf(fabsf(den), __expf(-mt));
            bf16x8 vf[4];
#pragma unroll
            for (int ks = 0; ks < 4; ++ks) vf[ks] = *(const bf16x8*)(Vt + (32 * eb + l31) * 144 + (ks * 16 + hh * 8) * 2);
            f32x16 acc1 = zero16(), acc2 = zero16();
#pragma unroll
            for (int ks = 0; ks < 4; ++ks) { const bf16x8 cf = *(const bf16x8*)(Cs + (32 * eb + l31) * 144 + (ks * 16 + hh * 8) * 2); acc1 = mfma32(cf, qf[ks], acc1); }
#pragma unroll
            for (int sb = 0; sb < 2; ++sb)
                if (sb <= tb) {
#pragma unroll
                    for (int s = 0; s < 2; ++s) acc2 = mfma32(vf[2 * sb + s], pack8(S[sb], s), acc2);
                }
            {
                bf16_t* op = HD + (size_t)ml_row(b, dir, p0 + t) * DM + h * 128 + 32 * eb;
#pragma unroll
                for (int ig = 0; ig < 4; ++ig) {
                    u32x2 p; p[0] = pk2((acc1[4 * ig] * inter + acc2[4 * ig]) * rinv, (acc1[4 * ig + 1] * inter + acc2[4 * ig + 1]) * rinv);
                    p[1] = pk2((acc1[4 * ig + 2] * inter + acc2[4 * ig + 2]) * rinv, (acc1[4 * ig + 3] * inter + acc2[4 * ig + 3]) * rinv);
                    *(u32x2*)(op + 8 * ig + 4 * hh) = p;
                }
            }
            Cacc = Cacc * decay;
#pragma unroll
            for (int ks = 0; ks < 4; ++ks) { const bf16x8 kg = *(const bf16x8*)(KgT + (32 * tb + l31) * 144 + (ks * 16 + hh * 8) * 2); Cacc = mfma32(vf[ks], kg, Cacc); }
            if (wid == 0) {
                float sum = 0.f;
#pragma unroll
                for (int j = 0; j < 8; ++j) { const u32x4 k8 = *(const u32x4*)(KgT + lane * 144 + j * 16); sum += bflo(k8[0]) + bfhi(k8[0]) + bflo(k8[1]) + bfhi(k8[1]) + bflo(k8[2]) + bfhi(k8[2]) + bflo(k8[3]) + bfhi(k8[3]); }
                nacc = nacc * decay + sum;
            }
            __syncthreads();
#pragma unroll
            for (int i = 0; i < 16; ++i) *(unsigned short*)(Cs + (32 * eb + crow(i, hh)) * 144 + (32 * tb + l31) * 2) = (unsigned short)(pk2(Cacc[i], 0.f) & 0xffffu);
            if (wid == 0) sN[lane] = nacc;
        }
#undef ML_GLOAD
    }
    __syncthreads();
}

DI void phase_ml_finish(const Args& a, int l, int nrows) {
    const bf16_t* HF = (const bf16_t*)(a.ws + WS_HF); const bf16_t* HB = (const bf16_t*)(a.ws + WS_HB);
    const bf16_t* QKV = (const bf16_t*)(a.ws + WS_QKV);
    bf16_t* ATT = (bf16_t*)(a.ws + WS_ATT);
    const float* ng = a.in[lbase(l) + 5];
    const int lane = otid() & 63, wid = otid() >> 6;
    for (int row = blockIdx.x * 8 + wid; row < nrows; row += gridDim.x * 8) {
        const int c0 = lane * 16;
        float v[16]; float ss = 0.f;
#pragma unroll
        for (int j = 0; j < 2; ++j) {
            const u32x4 f = *(const u32x4*)(HF + (size_t)row * DM + c0 + 8 * j), bk = *(const u32x4*)(HB + (size_t)row * DM + c0 + 8 * j);
#pragma unroll
            for (int i = 0; i < 4; ++i) { v[8 * j + 2 * i] = bflo(f[i]) + bflo(bk[i]); v[8 * j + 2 * i + 1] = bfhi(f[i]) + bfhi(bk[i]); }
        }
#pragma unroll
        for (int i = 0; i < 16; ++i) ss += v[i] * v[i];
        ss += __shfl_xor(ss, 1); ss += __shfl_xor(ss, 2); ss += __shfl_xor(ss, 4);
        const float rstd = rsqrtf(ss * (1.0f / 128.0f) + 1e-6f);
#pragma unroll
        for (int j = 0; j < 2; ++j) {
            const u32x4 o8 = *(const u32x4*)(QKV + (size_t)row * 3328 + 2048 + c0 + 8 * j);
            const f32x4 g0 = *(const f32x4*)(ng + c0 + 8 * j), g1 = *(const f32x4*)(ng + c0 + 8 * j + 4);
            float y[8];
#pragma unroll
            for (int i = 0; i < 4; ++i) {
                const float oa = bflo(o8[i]), ob = bfhi(o8[i]);
                const float ga = i < 2 ? g0[2 * i] : g1[2 * i - 4], gb = i < 2 ? g0[2 * i + 1] : g1[2 * i - 3];
                y[2 * i] = v[8 * j + 2 * i] * rstd * ga / (1.f + __expf(-oa));
                y[2 * i + 1] = v[8 * j + 2 * i + 1] * rstd * gb / (1.f + __expf(-ob));
            }
            u32x4 p; p[0] = pk2(y[0], y[1]); p[1] = pk2(y[2], y[3]); p[2] = pk2(y[4], y[5]); p[3] = pk2(y[6], y[7]);
            *(u32x4*)(ATT + (size_t)row * DM + c0 + 8 * j) = p;
        }
    }
}

DI void phase_conv(const Args& a, int l, int half, int nrows) {
    const bf16_t* U = (const bf16_t*)(a.ws + WS_U);
    bf16_t* ACT = (bf16_t*)(a.ws + WS_ACT);
    const int kind = l % 3, bs = lbase(l);
    const float* cw = a.in[bs + off_wout(kind) + 3]; const float* cb = a.in[bs + off_wout(kind) + 4];
    const float* ssq = (const float*)(a.ws + WS_SSQ) + (size_t)(2 * l + 1) * MROWS;
    const float* sb_up = (const float*)(a.ws + WS_SB) + (size_t)l * SB_LAYER + 9 * SB_IN_LD + (half ? UP_T0 * 256 : 0);
    const int upitch = half ? (22 - UP_T0) * 256 : UP_T0 * 256, cpr = upitch >> 3, c0 = half ? UP_T0 * 128 : 0;
    const int nunits = (nrows >> 3) * cpr;
    for (int u = blockIdx.x * 512 + otid(); u < nunits; u += gridDim.x * 512) {
        const int strip = u / cpr, chunk = u - strip * cpr, r0 = strip * 8;
        const int fa = c0 + chunk * 4, uca = 256 * (chunk >> 5) + 4 * (chunk & 31);
        const int ub = r0 < MLAT ? (r0 >> 11) : 8;
        f32x4 wa[3], wg[3];
#pragma unroll
        for (int j = 0; j < 3; ++j) { wa[j] = *(const f32x4*)(cw + (size_t)j * 2 * FFN + fa); wg[j] = *(const f32x4*)(cw + (size_t)j * 2 * FFN + FFN + fa); }
        const f32x4 ba = *(const f32x4*)(cb + fa), bg = *(const f32x4*)(cb + FFN + fa);
        const f32x4 sa = *(const f32x4*)(sb_up + (size_t)ub * SB_UP_LD + uca), sg = *(const f32x4*)(sb_up + (size_t)ub * SB_UP_LD + uca + 128);
        const bool has_prev = r0 < MLAT ? (r0 & 2047) != 0 : ((r0 - MLAT) & 255) != 0;
        const int rn = r0 + 8;
        const bool has_next = rn < MLAT ? (rn & 2047) != 0 : (rn < MROWS && ((rn - MLAT) & 255) != 0);
        const bf16_t* up = U + (size_t)r0 * upitch + uca;
        u32x2 ua[10], ug[10]; float rsv[10];
#pragma unroll
        for (int i = 0; i < 10; ++i) {
            int ro = i - 1; if (i == 0 && !has_prev) ro = 0; if (i == 9 && !has_next) ro = 7;
            const bf16_t* rp = up + (ptrdiff_t)ro * upitch;
            ua[i] = *(const u32x2*)(rp); ug[i] = *(const u32x2*)(rp + 128); rsv[i] = ssq[r0 + ro];
        }
        f32x4 xa[10], xg[10];
#pragma unroll
        for (int i = 0; i < 10; ++i) {
            const float rs_ = rsqrtf(rsv[i] * (1.0f / 1024.0f) + 1e-6f);
            xa[i] = (f32x4){bflo(ua[i][0]), bfhi(ua[i][0]), bflo(ua[i][1]), bfhi(ua[i][1])} * rs_ + sa;
            xg[i] = (f32x4){bflo(ug[i][0]), bfhi(ug[i][0]), bflo(ug[i][1]), bfhi(ug[i][1])} * rs_ + sg;
        }
        const float fp = has_prev ? 1.f : 0.f, fn = has_next ? 1.f : 0.f;
        xa[0] = xa[0] * fp; xg[0] = xg[0] * fp; xa[9] = xa[9] * fn; xg[9] = xg[9] * fn;
#pragma unroll
        for (int i = 0; i < 8; ++i) {
            const f32x4 av = ba + wa[0] * xa[i] + wa[1] * xa[i + 1] + wa[2] * xa[i + 2];
            const f32x4 gv = bg + wg[0] * xg[i] + wg[1] * xg[i + 1] + wg[2] * xg[i + 2];
            float y[4];
#pragma unroll
            for (int q = 0; q < 4; ++q) y[q] = av[q] * gv[q] / (1.f + __expf(-gv[q]));
            u32x2 p; p[0] = pk2(y[0], y[1]); p[1] = pk2(y[2], y[3]);
            *(u32x2*)(ACT + (size_t)(r0 + i) * FFN + fa) = p;
        }
    }
}

DI void phase_conv_fix(const Args& a, int l, int nrows) {
    const float* EDGE = (const float*)(a.ws + WS_U);
    bf16_t* ACT = (bf16_t*)(a.ws + WS_ACT);
    const int kind = l % 3, bs = lbase(l);
    const float* cw = a.in[bs + off_wout(kind) + 3]; const float* cb = a.in[bs + off_wout(kind) + 4];
    const int nb = (nrows >> 6) - 1, total = nb * 704;
    for (int u = blockIdx.x * 512 + otid(); u < total; u += gridDim.x * 512) {
        const int bb = u / 704, ch = (u - bb * 704) * 4, r = 64 * (bb + 1);
        const bool interior = r < MLAT ? (r & 2047) != 0 : ((r - MLAT) & 255) != 0;
        if (!interior) continue;
        const float* eA = EDGE + ((size_t)(bb * 4 + 2) * 2) * FFN + ch;
        const float* eB = eA + 2 * FFN;
        const float* eC = EDGE + ((size_t)((bb + 1) * 4) * 2) * FFN + ch;
        const float* eD = eC + 2 * FFN;
        f32x4 wa[3], wg[3];
#pragma unroll
        for (int j = 0; j < 3; ++j) { wa[j] = *(const f32x4*)(cw + (size_t)j * 2 * FFN + ch); wg[j] = *(const f32x4*)(cw + (size_t)j * 2 * FFN + FFN + ch); }
        const f32x4 ba = *(const f32x4*)(cb + ch), bg = *(const f32x4*)(cb + FFN + ch);
        const f32x4 aA = *(const f32x4*)(eA), gA = *(const f32x4*)(eA + FFN), aB = *(const f32x4*)(eB), gB = *(const f32x4*)(eB + FFN);
        const f32x4 aC = *(const f32x4*)(eC), gC = *(const f32x4*)(eC + FFN), aD = *(const f32x4*)(eD), gD = *(const f32x4*)(eD + FFN);
        const f32x4 a1 = ba + wa[0] * aA + wa[1] * aB + wa[2] * aC, g1 = bg + wg[0] * gA + wg[1] * gB + wg[2] * gC;
        const f32x4 a2 = ba + wa[0] * aB + wa[1] * aC + wa[2] * aD, g2 = bg + wg[0] * gB + wg[1] * gC + wg[2] * gD;
        float y[4], z[4];
#pragma unroll
        for (int q = 0; q < 4; ++q) { y[q] = a1[q] * g1[q] / (1.f + __expf(-g1[q])); z[q] = a2[q] * g2[q] / (1.f + __expf(-g2[q])); }
        u32x2 p; p[0] = pk2(y[0], y[1]); p[1] = pk2(y[2], y[3]);
        *(u32x2*)(ACT + (size_t)(r - 1) * FFN + ch) = p;
        p[0] = pk2(z[0], z[1]); p[1] = pk2(z[2], z[3]);
        *(u32x2*)(ACT + (size_t)r * FFN + ch) = p;
    }
}

#define XB_TMO      128
#define XB_XCNT(j)  (256  + 64 * (j))
#define XB_XSUB(j)  (1280 + 64 * (j))
#define XB_XGEN(j)  (2304 + 64 * (j))
#define XB_TOP      3328
#define XB_TOPGEN   3392
#define XCD_BAR_WORDS 3456
#define XB_SPIN_CAP (1u << 18)

__device__ __forceinline__ unsigned xb_ld(unsigned* p)              { return __hip_atomic_load(p, __ATOMIC_RELAXED, __HIP_MEMORY_SCOPE_AGENT); }
__device__ __forceinline__ unsigned xb_add(unsigned* p, unsigned v) { return __hip_atomic_fetch_add(p, v, __ATOMIC_RELAXED, __HIP_MEMORY_SCOPE_AGENT); }
__device__ __forceinline__ unsigned xb_xcc_id() { return (unsigned)__builtin_amdgcn_s_getreg((3 << 11) | 20) & 0xFu; }
#define XB_SPIN(cond, bar) do { unsigned _sp = 0; while (cond) { __builtin_amdgcn_s_sleep(1); \
    if ((++_sp & 255u) == 0u) { if (xb_ld(&(bar)[XB_TMO])) break; if (_sp > XB_SPIN_CAP) { atomicAdd(&(bar)[XB_TMO], 1u); break; } } } } while (0)

struct XcdBarrier {
    unsigned* bar; unsigned x;
    volatile LAS unsigned* st;
};

__device__ __forceinline__ XcdBarrier xcd_barrier_post(unsigned* bar, volatile LAS unsigned* st) {
    XcdBarrier b; b.bar = bar; b.x = xb_xcc_id(); b.st = st;
    if (otid() == 0) (void)xb_add(&bar[XB_XCNT(b.x)], 1u);
    return b;
}
__device__ __forceinline__ void xcd_barrier_complete(unsigned* bar, unsigned x, unsigned& nloc, unsigned& nx) {
    const unsigned G = gridDim.x * gridDim.y * gridDim.z;
    unsigned sum, cnt, mine, sp = 0u;
    for (;;) {
        sum = 0u; cnt = 0u; mine = 0u;
#pragma unroll
        for (unsigned j = 0; j < 16; ++j) { const unsigned c = xb_ld(&bar[XB_XCNT(j)]); sum += c; cnt += (c > 0u) ? 1u : 0u; mine = (j == x) ? c : mine; }
        if (sum == G) break;
        __builtin_amdgcn_s_sleep(1);
        if ((++sp & 255u) == 0u) { if (xb_ld(&bar[XB_TMO])) break; if (sp > XB_SPIN_CAP) { atomicAdd(&bar[XB_TMO], 1u); break; } }
    }
    nloc = mine > 0u ? mine : 1u; nx = cnt > 0u ? cnt : 1u;
}

__device__ __forceinline__ void xcd_barrier(const XcdBarrier& b) {
    asm volatile("s_waitcnt vmcnt(0)" ::: "memory");
    __syncthreads();
    if (otid() == 0) {
        unsigned* bar = b.bar;
        __builtin_amdgcn_s_waitcnt(0);
        unsigned nloc = b.st[0], nx = b.st[1];
        if (nloc == 0u) { xcd_barrier_complete(bar, b.x, nloc, nx); b.st[0] = nloc; b.st[1] = nx; }
        const unsigned old = xb_add(&bar[XB_XSUB(b.x)], 1u);
        const unsigned gen = old / nloc;
        if (old + 1u == (gen + 1u) * nloc) {
            __builtin_amdgcn_fence(__ATOMIC_RELEASE, "agent");
            asm volatile("s_waitcnt vmcnt(0)" ::: "memory");
            const unsigned og = xb_add(&bar[XB_TOP], 1u);
            const unsigned tg = og / nx;
            if (og + 1u == (tg + 1u) * nx) xb_add(&bar[XB_TOPGEN], 1u);
            else XB_SPIN(xb_ld(&bar[XB_TOPGEN]) == tg, bar);
            __builtin_amdgcn_fence(__ATOMIC_ACQUIRE, "agent");
            xb_add(&bar[XB_XGEN(b.x)], 1u);
            asm volatile("s_waitcnt vmcnt(0)" ::: "memory");
        } else {
            XB_SPIN(xb_ld(&bar[XB_XGEN(b.x)]) == gen, bar);
            __builtin_amdgcn_fence(__ATOMIC_ACQUIRE, "agent");
            asm volatile("s_waitcnt vmcnt(0)" ::: "memory");
        }
    }
    __syncthreads();
}

__host__ __device__ inline bool phase_active(int ph) {
    if (ph == 0 || ph == 45) return true;
    const int l = (ph - 1) / 11, s = (ph - 1) % 11;
    if (s == 3) return (l % 3) == 1;
    if (s == 5 || s == 8 || s == 9) return false;
    if (s == 0) return l == 0;
    return true;
}

DI void run_phase(const Args& a, char* shm, int ph) {
    if (ph == 0) { phase_prologue(a, shm); return; }
    float* X = (float*)(a.ws + WS_X);
    if (ph == 45) { phase_final_norm(X, a.in[57], a.out); return; }
    const int l = (ph - 1) / 11, s = (ph - 1) % 11, kind = l % 3, bs = lbase(l);
    const bool need_ctx = l < 3;
    const int Mff = need_ctx ? MROWS : MLAT;
    const float* mod_l = (const float*)(a.ws + WS_MOD) + (size_t)l * 9 * 6144;
    const float* Xl = l == 0 ? a.in[0] : X; const float* Xc = l == 0 ? a.in[2] : X + (size_t)MLAT * DM;
    bf16_t* H = (bf16_t*)(a.ws + WS_H);
    unsigned char* wb = a.ws + WS_W;
    float* ssq1 = (float*)(a.ws + WS_SSQ) + (size_t)(2 * l) * MROWS; float* ssq2 = ssq1 + MROWS;
    const float* sb_in = (const float*)(a.ws + WS_SB) + (size_t)l * SB_LAYER; const float* sb_up = sb_in + 9 * SB_IN_LD;
    if (s == 1 || s == 4 || s == 6 || s == 8 || s == 10) {
        Epi E; E.mode = 0; E.O = nullptr; E.ldo = 0; E.ropelim = 0; E.ropec = (const float*)(a.ws + WS_ROPE); E.ropes = E.ropec + 1024;
        E.G = (float*)(a.ws + WS_G); E.gate_b = nullptr; E.X = X; E.res_lat = nullptr; E.res_ctx = nullptr; E.gate = nullptr;
        E.ssq_in = nullptr; E.sbias = nullptr; E.sb_ld = 0; E.Hout = nullptr; E.hgain = (const float*)(a.ws + WS_HG); E.ssq_out = nullptr;
        E.cw = nullptr; E.cb = nullptr; E.ACT = nullptr; E.EDGE = nullptr;
        const bf16_t* A = H; const bf16_t* Bt = (const bf16_t*)(wb + WOFF_IN); int M = MROWS, N = 1024, K = 1024;
        if (s == 1) {
            E.O = (bf16_t*)(a.ws + WS_QKV); E.ldo = ninpad_of(kind); N = ninpad_of(kind);
            E.ssq_in = ssq1; E.sbias = sb_in; E.sb_ld = SB_IN_LD;
            if (kind == 0) { E.ropelim = 2048; } else if (kind == 1) { E.mode = 1; E.gate_b = a.in[bs + 4]; } else { E.ropelim = 1280; }
        } else if (s == 4) {
            E.mode = 2; E.res_lat = Xl; E.res_ctx = Xc; E.gate = mod_l + 2048;
            E.Hout = H; E.hgain = (const float*)(a.ws + WS_HG) + (size_t)((4 + l) * 9) * 1024; E.ssq_out = ssq2;
            A = (const bf16_t*)(a.ws + WS_ATT); Bt = (const bf16_t*)(wb + WOFF_OUT); M = Mff;
        } else if (s == 10) {
            E.mode = 2; E.res_lat = X; E.res_ctx = X + (size_t)MLAT * DM; E.gate = mod_l + 5120;
            if (l < 3) { E.Hout = H; E.hgain = (const float*)(a.ws + WS_HG) + (size_t)((l + 1) * 9) * 1024; E.ssq_out = ssq1 + 2 * MROWS; }
            A = (const bf16_t*)(a.ws + WS_ACT); Bt = (const bf16_t*)(wb + WOFF_DOWN); M = Mff; K = FFN;
        } else {
            E.mode = 4; N = 2 * FFN; M = Mff;
            E.ssq_in = ssq2; E.sbias = sb_up; E.sb_ld = SB_UP_LD;
            E.cw = a.in[bs + off_wout(kind) + 3]; E.cb = a.in[bs + off_wout(kind) + 4]; E.ACT = (bf16_t*)(a.ws + WS_ACT); E.EDGE = (float*)(a.ws + WS_U);
            Bt = (const bf16_t*)(wb + WOFF_UP);
        }
        if (s == 1 && kind != 1) {
            float* rl = (float*)(shm + 131072 + 1024 + 10240);
            for (int i = otid(); i < 2048; i += 512) rl[i] = E.ropec[i];
            __syncthreads();
        }
        run_gemm(shm, A, Bt, M, N, K, E);
        {
            int cl = -1, which = 0;
            if (s == 1 && l >= 1) { cl = l; which = 8; }
            else if (s == 4 && l <= 2) { cl = l + 1; which = 1; }
            else if (s == 10 && l <= 2) { cl = l + 1; which = 6; }
            if (cl >= 0) {
                const int nwg = (M >> 8) * (N >> 8), G = (int)gridDim.x, rem = nwg % G, c = (int)blockIdx.x;
                if (rem == 0) phase_convert(a, shm, cl, which, c, G);
                else if (c >= rem) phase_convert(a, shm, cl, which, c - rem, G - rem);
            }
        }
        return;
    }
    switch (s) {
    case 0:
        phase_convert(a, shm, 0, 15, (int)blockIdx.x, (int)gridDim.x);
        {
            float* HG = (float*)(a.ws + WS_HG); const float* modb = (const float*)(a.ws + WS_MOD);
            for (int i = blockIdx.x * 512 + otid(); i < 2 * 4 * 9 * 1024; i += gridDim.x * 512) {
                const int c = i & 1023, rb = (i >> 10) % 9, tl = i / (9 * 1024), ll = tl & 3, t = tl >> 2, kk = ll % 3;
                const float g = t ? a.in[lbase(ll) + off_wout(kk) + 1][c] : a.in[lbase(ll) + 2][c];
                HG[i] = g * (1.0f + modb[(size_t)(ll * 9 + rb) * 6144 + (t ? 4096 : 1024) + c]);
            }
        }
        phase_prenorm(Xl, Xc, a.in[bs + 2], mod_l, 1024, H, ssq1, MROWS);
        break;
    case 2:
#ifndef NO_DA
        if (kind == 0) phase_da(a, shm, l, need_ctx);
#endif
#ifndef NO_ML
        if (kind == 1) phase_mlstm(a, shm);
#endif
#ifndef NO_SWA
        if (kind == 2) phase_swa(a, shm, l, need_ctx);
#endif
        break;
    case 3:
        phase_ml_finish(a, l, Mff);
        break;
    case 7:
        phase_conv_fix(a, l, Mff);
        break;
    }
}

__global__ void __launch_bounds__(512, 2) mega_fwd(Args a) {
    extern __shared__ __attribute__((aligned(16))) char shm[];
    volatile LAS unsigned* st = (volatile LAS unsigned*)((LAS char*)shm + 131072 + 256);
    if (otid() == 0) { st[0] = 0u; st[1] = 0u; }
    __syncthreads();
    XcdBarrier xb = xcd_barrier_post((unsigned*)(a.ws + WS_BAR), st);
    for (int ph = a.ph_lo; ph < a.ph_hi; ++ph) {
        if (!phase_active(ph)) continue;
        int reps = 1;
#ifdef PROBE_REP
        if (ph > 0 && ph < 45) {
            const int l_ = (ph - 1) / 11, s_ = (ph - 1) % 11, k_ = l_ % 3;
            bool rep = false;
            if (PROBE_REP == 1) rep = (s_ == 1);
            if (PROBE_REP == 2) rep = (s_ == 6);
            if (PROBE_REP == 3) rep = (s_ == 2 && k_ == 0);
            if (PROBE_REP == 4) rep = (s_ == 2 && k_ != 0) || s_ == 3;
            if (PROBE_REP == 5) rep = (s_ == 7);
            if (rep) reps = 2;
        }
#endif
        for (int r = 0; r < reps; ++r) {
            run_phase(a, shm, ph);
            if (a.use_sync && (ph + 1 < a.ph_hi || r + 1 < reps)) {
                if (a.use_sync == 2) cg::this_grid().sync();
                xcd_barrier(xb);
            }
        }
    }
}

extern "C" void kernel_launch(void* const* d_in, const int* in_sizes, int n_in, void* d_out, int out_size, void* d_ws, size_t ws_size, hipStream_t stream) {
    static int grid_blocks = 0;
    if (!grid_blocks) {
        int dev = 0, cus = 0, per_cu = 0;
        hipGetDevice(&dev);
        hipDeviceGetAttribute(&cus, hipDeviceAttributeMultiprocessorCount, dev);
        hipFuncSetAttribute((const void*)mega_fwd, hipFuncAttributeMaxDynamicSharedMemorySize, LDS_BYTES);
        hipOccupancyMaxActiveBlocksPerMultiprocessor(&per_cu, mega_fwd, 512, LDS_BYTES);
        if (per_cu < 1) { fprintf(stderr, "occupancy query returned %d\n", per_cu); per_cu = 1; }
        grid_blocks = cus * 1;
    }
    Args a{};
    for (int i = 0; i < 58; ++i) a.in[i] = (const float*)d_in[i];
    a.out = (float*)d_out; a.ws = (unsigned char*)d_ws; a.pad = 0;
#if MK_ONE_LAUNCH
    a.ph_lo = 0; a.ph_hi = NPHASE; a.use_sync = 1;
    hipMemsetAsync((char*)d_ws + WS_BAR, 0, ZERO_BYTES, stream);
    void* args[] = {&a};
    hipError_t e = hipLaunchCooperativeKernel((const void*)mega_fwd, dim3(grid_blocks), dim3(512), args, LDS_BYTES, stream);
    if (e != hipSuccess) fprintf(stderr, "cooperative launch failed: %s (grid %d)\n", hipGetErrorString(e), grid_blocks);
#else
    a.use_sync = 0;
    for (int ph = 0; ph < NPHASE; ++ph) {
        if (!phase_active(ph)) continue;
        a.ph_lo = ph; a.ph_hi = ph + 1;
        hipLaunchKernelGGL(mega_fwd, dim3(grid_blocks), dim3(512), LDS_BYTES, stream, a);
    }
#endif
}
```

```cpp
#include <hip/hip_runtime.h>
#include <hip/hip_cooperative_groups.h>
#include <cstdio>
#include <type_traits>
namespace cg = cooperative_groups;

#ifndef MK_ONE_LAUNCH
#define MK_ONE_LAUNCH 1
#endif

#define DI __device__ __forceinline__
typedef float f32x2 __attribute__((ext_vector_type(2)));
typedef float f32x16 __attribute__((ext_vector_type(16)));
typedef unsigned u32x2 __attribute__((ext_vector_type(2)));
typedef __bf16 bf16x2_t __attribute__((ext_vector_type(2)));

namespace pg8 {
#define PG8_LAS __attribute__((address_space(3)))
typedef unsigned short bf16_t;
typedef short bf16x8 __attribute__((ext_vector_type(8)));
typedef float f32x4 __attribute__((ext_vector_type(4)));
typedef unsigned u32x4 __attribute__((ext_vector_type(4)));
constexpr int BM = 256, BK = 64, HALF = 128, HTB = HALF * BK * 2  , STAGE_BYTES = 8 * HTB, NXCD = 8, WGM = 8;

__host__ __device__ __forceinline__ int lds_byte(int r, int c) { const int st = (r >> 4) * 2 + (c >> 5), rr = r & 15, cc = c & 31, ob = rr * 64 + cc * 2; return st * 1024 + (ob ^ (((ob >> 9) & 1) << 5)); }
__host__ __device__ __forceinline__ void stage_rc(int b, int& R, int& C) { const int st = b / 1024, sb = b % 1024, swz = sb ^ (((sb >> 9) & 1) << 5); R = (st >> 1) * 16 + swz / 64; C = (st & 1) * 32 + (swz % 64) / 2; }
__host__ __device__ __forceinline__ int perm32(int rho) { const int n = rho >> 4, i = rho & 15; return 8 * (i >> 2) + 4 * n + (i & 3); }

struct Unit { int pm, pn; };
struct Gemm { const bf16_t* A; const bf16_t* Bt; int M, N, K; };

struct StaticOrder {
    int nM, nN, nwg, G, c;
    __host__ __device__ void init(int M, int N, int G_, int c_) { nM = M / BM; nN = N / BM; nwg = nM * nN; G = G_; c = c_; }
    __host__ __device__ bool next(int i, Unit& u) const {
        const long L = (long)i * G + c; if (L >= nwg) return false;
        int wgid = (int)L; { const int q = nwg / NXCD, r = nwg % NXCD, xcd = wgid % NXCD, off = wgid / NXCD; wgid = (xcd < r ? xcd * (q + 1) : r * (q + 1) + (xcd - r) * q) + off; }
        const int nig = WGM * nN, gid = wgid / nig, fm = gid * WGM, gsz = (nM - fm) < WGM ? (nM - fm) : WGM;
        u.pm = fm + ((wgid % nig) % gsz); u.pn = (wgid % nig) / gsz; return true;
    }
    __device__ __forceinline__ void a_ready(const Unit&) const {}
    __device__ __forceinline__ void done(const Unit&) const {}
};

template <class Epi, class Sched>
__device__ __forceinline__ void gemm_phase(PG8_LAS unsigned char* lds, const Gemm g, const Sched& S, const Epi& E) {
    int tid = threadIdx.x; asm volatile("" : "+v"(tid)); const int wid = __builtin_amdgcn_readfirstlane(tid >> 6), wr = wid >> 2, wc = wid & 3;
    const int K = g.K, nt = K / BK;
    const size_t kstep = (size_t)(BK * 2);
    const size_t hstep = (size_t)HALF * K * 2;
    const size_t tstep = 2 * hstep;
    const unsigned ldsw = (unsigned)wid * 1024u;
    unsigned voffA[2], voffB[2]; int aoff, boff;
#define PG8_DERIVE() do { int t_ = tid; asm volatile("" : "+v"(t_)); const int ln_ = t_ & 63, fr_ = ln_ & 15, fq_ = ln_ >> 4; \
        _Pragma("unroll") for (int i = 0; i < 2; ++i) { int R, C; stage_rc(t_ * 16 + i * 8192, R, C); const int Rb = Epi::PERM ? ((R & ~31) + perm32(R & 31)) : R; \
            voffA[i] = (unsigned)(R * K + C) * 2u; voffB[i] = (unsigned)(Rb * K + C) * 2u; } \
        aoff = lds_byte(wr * 64 + fr_, fq_ * 8); boff = lds_byte(wc * 32 + fr_, fq_ * 8); } while (0)
    PG8_DERIVE();
#define PG8_SA(b, h) (((b) * 2 + (h)) * HTB)
#define PG8_SB(b, h) ((4 + (b) * 2 + (h)) * HTB)
#define PG8_STAGE(bufoff, gbase, voff) do { _Pragma("unroll") for (int _i = 0; _i < 2; ++_i) \
        __builtin_amdgcn_global_load_lds((const unsigned*)((const char*)(gbase) + (voff)[_i]), (PG8_LAS unsigned*)(lds + (bufoff) + ldsw + _i * 8192), 16, 0, 0); } while (0)
#define PG8_LDA(dst, b, h) do { _Pragma("unroll") for (int m = 0; m < 4; ++m) _Pragma("unroll") for (int k = 0; k < 2; ++k) dst[m][k] = *(const PG8_LAS bf16x8*)(lds + PG8_SA(b, h) + aoff + m * 2048 + k * 1024); } while (0)
#define PG8_LDB(dst, b, h) do { _Pragma("unroll") for (int n = 0; n < 2; ++n) _Pragma("unroll") for (int k = 0; k < 2; ++k) dst[n][k] = *(const PG8_LAS bf16x8*)(lds + PG8_SB(b, h) + boff + n * 2048 + k * 1024); } while (0)
#define PG8_MMA(ai, bj, At, Bt) do { __builtin_amdgcn_s_setprio(1); _Pragma("unroll") for (int m = 0; m < 4; ++m) _Pragma("unroll") for (int n = 0; n < 2; ++n) _Pragma("unroll") for (int k = 0; k < 2; ++k) \
        acc[ai][bj][m][n] = __builtin_amdgcn_mfma_f32_16x16x32_bf16(Bt[n][k], At[m][k], acc[ai][bj][m][n], 0, 0, 0); __builtin_amdgcn_s_setprio(0); } while (0)
#define PG8_WAIT_V(n) asm volatile("s_waitcnt vmcnt(" #n ")" ::: "memory")
#define PG8_WAIT_L(n) asm volatile("s_waitcnt lgkmcnt(" #n ")" ::: "memory")
#define PG8_BAR __builtin_amdgcn_s_barrier()
#define PG8_SCHED __builtin_amdgcn_sched_barrier(0)
    Unit cur, nxt; int ui = 0;
    if (!S.next(0, cur)) return;
    f32x4 acc[2][2][4][2];
#pragma unroll
    for (int a = 0; a < 2; ++a)
#pragma unroll
        for (int b = 0; b < 2; ++b)
#pragma unroll
            for (int m = 0; m < 4; ++m)
#pragma unroll
                for (int n = 0; n < 2; ++n) acc[a][b][m][n] = (f32x4){0.f, 0.f, 0.f, 0.f};
    bf16x8 At[4][2], B0[2][2], B1[2][2];
    const char* cA = (const char*)g.A + (size_t)cur.pm * tstep; const char* cB = (const char*)g.Bt + (size_t)cur.pn * tstep;
    S.a_ready(cur);
    PG8_STAGE(PG8_SB(0, 0), cB, voffB); PG8_STAGE(PG8_SA(0, 0), cA, voffA); PG8_STAGE(PG8_SB(0, 1), cB + hstep, voffB); PG8_STAGE(PG8_SA(0, 1), cA + hstep, voffA);
    if (wr == 1) PG8_BAR;
    PG8_WAIT_V(4); PG8_BAR;
    PG8_STAGE(PG8_SB(1, 0), cB + kstep, voffB); PG8_STAGE(PG8_SA(1, 0), cA + kstep, voffA); PG8_STAGE(PG8_SB(1, 1), cB + hstep + kstep, voffB);
    PG8_WAIT_V(6); PG8_BAR;
    for (;;) {
        const bool has_next = S.next(ui + 1, nxt);
        const char* nA = has_next ? (const char*)g.A + (size_t)nxt.pm * tstep : cA; const char* nB = has_next ? (const char*)g.Bt + (size_t)nxt.pn * tstep : cB;
        for (int t = 0; t < nt; t += 2) {
            const bool last = (t == nt - 2);
            const char* a1 = cA + (size_t)(t + 1) * kstep;
            const char* a2 = last ? nA : cA + (size_t)(t + 2) * kstep; const char* b2 = last ? nB : cB + (size_t)(t + 2) * kstep;
            const char* a3 = a2 + kstep; const char* b3 = b2 + kstep;
            if (last && has_next) S.a_ready(nxt);
            PG8_LDB(B0, 0, 0); PG8_SCHED; PG8_LDA(At, 0, 0); PG8_STAGE(PG8_SA(1, 1), a1 + hstep, voffA);
            PG8_WAIT_L(8); PG8_BAR; PG8_WAIT_L(0); PG8_MMA(0, 0, At, B0); PG8_BAR; PG8_SCHED;
            PG8_LDB(B1, 0, 1); PG8_STAGE(PG8_SB(0, 0), b2, voffB);
            PG8_BAR; PG8_WAIT_L(0); PG8_MMA(0, 1, At, B1); PG8_BAR;
            PG8_LDA(At, 0, 1); PG8_STAGE(PG8_SA(0, 0), a2, voffA);
            PG8_BAR; PG8_WAIT_L(0); PG8_MMA(1, 0, At, B0); PG8_BAR; PG8_SCHED;
            PG8_STAGE(PG8_SB(0, 1), b2 + hstep, voffB);
            PG8_WAIT_V(6); PG8_BAR; PG8_MMA(1, 1, At, B1); PG8_BAR;
            PG8_LDB(B0, 1, 0); PG8_SCHED; PG8_LDA(At, 1, 0); PG8_STAGE(PG8_SA(0, 1), a2 + hstep, voffA);
            PG8_WAIT_L(8); PG8_BAR; PG8_WAIT_L(0); PG8_MMA(0, 0, At, B0); PG8_BAR; PG8_SCHED;
            PG8_LDB(B1, 1, 1); PG8_STAGE(PG8_SB(1, 0), b3, voffB);
            PG8_BAR; PG8_WAIT_L(0); PG8_MMA(0, 1, At, B1); PG8_BAR;
            PG8_LDA(At, 1, 1); PG8_STAGE(PG8_SA(1, 0), a3, voffA);
            PG8_BAR; PG8_WAIT_L(0); PG8_MMA(1, 0, At, B0); PG8_BAR; PG8_SCHED;
            PG8_STAGE(PG8_SB(1, 1), b3 + hstep, voffB);
            PG8_WAIT_V(6); PG8_BAR; PG8_MMA(1, 1, At, B1); PG8_BAR;
        }
        if constexpr (!Epi::AFTER_DRAIN) { { int t_ = tid; asm volatile("" : "+v"(t_)); const int ln_ = t_ & 63; E(acc, cur, wr, wc, ln_ & 15, ln_ >> 4); } S.done(cur); PG8_DERIVE(); }
        if (!has_next) break;
#pragma unroll
        for (int a = 0; a < 2; ++a)
#pragma unroll
            for (int b = 0; b < 2; ++b)
#pragma unroll
                for (int m = 0; m < 4; ++m)
#pragma unroll
                    for (int n = 0; n < 2; ++n) acc[a][b][m][n] = (f32x4){0.f, 0.f, 0.f, 0.f};
        cur = nxt; cA = nA; cB = nB; ++ui;
    }
    PG8_WAIT_V(0);
    if (wr == 0) PG8_BAR;
    PG8_BAR;
    if constexpr (Epi::AFTER_DRAIN) { const int lane = tid & 63; E.fused(acc, cur, wr, wc, lane & 15, lane >> 4, lds, wid, lane); S.done(cur); }
#undef PG8_SA
#undef PG8_DERIVE
#undef PG8_SB
#undef PG8_STAGE
#undef PG8_LDA
#undef PG8_LDB
#undef PG8_MMA
#undef PG8_WAIT_V
#undef PG8_WAIT_L
#undef PG8_BAR
#undef PG8_SCHED
}
}

using pg8::bf16_t; using pg8::bf16x8; using pg8::f32x4; using pg8::u32x4;
#define LAS __attribute__((address_space(3)))
DI int otid() { int t = threadIdx.x; asm volatile("" : "+v"(t)); return t; }

constexpr int MROWS = 18432, MLAT = 16384, DM = 1024, FFN = 2816, FH = 1408;
constexpr size_t MiB = 1u << 20;
constexpr size_t WS_X = 0, WS_W = 72 * MiB, WS_H = 97 * MiB, WS_QKV = 133 * MiB, WS_U = 133 * MiB, WS_ACT = 241 * MiB,
                 WS_ATT = 250 * MiB, WS_HF = 286 * MiB, WS_HB = WS_H, WS_G = 322 * MiB, WS_MOD = 340 * MiB, WS_ROPE = 341 * MiB, WS_BAR = 342 * MiB, WS_SSQ = 343 * MiB, WS_SB = 344 * MiB, WS_HG = 349 * MiB;
constexpr int UP_T0 = 12;
constexpr int SB_IN_LD = 3328, SB_UP_LD = 5632;
constexpr size_t SB_LAYER = (size_t)9 * (SB_IN_LD + SB_UP_LD);
constexpr size_t ZERO_BYTES = 4 * MiB;
constexpr size_t WOFF_IN = 0, WOFF_OUT = 13 * MiB / 2, WOFF_UP = 17 * MiB / 2, WOFF_DOWN = 39 * MiB / 2;
constexpr int LDS_BYTES = 151552;
constexpr int NPHASE = 46;

struct Args { const float* in[58]; float* out; unsigned char* ws; int ph_lo, ph_hi, use_sync, pad; };

DI int lbase(int l) { return l == 0 ? 4 : l == 1 ? 19 : l == 2 ? 31 : 42; }
DI int off_wout(int k) { return k == 0 ? 9 : k == 1 ? 6 : 5; }
DI int nin_of(int k) { return k == 0 ? 3072 : k == 1 ? 3104 : 1536; }
DI int ninpad_of(int k) { return k == 0 ? 3072 : k == 1 ? 3328 : 1536; }

DI unsigned pk2(float lo, float hi) { f32x2 v = {lo, hi}; bf16x2_t b = __builtin_convertvector(v, bf16x2_t); return __builtin_bit_cast(unsigned, b); }
DI float bflo(unsigned u) { return __uint_as_float(u << 16); }
DI float bfhi(unsigned u) { return __uint_as_float(u & 0xffff0000u); }
DI f32x16 mfma32(bf16x8 a, bf16x8 b, f32x16 c) { return __builtin_amdgcn_mfma_f32_32x32x16_bf16(a, b, c, 0, 0, 0); }
DI int crow(int i, int h) { return (i & 3) + 8 * (i >> 2) + 4 * h; }
DI float fexp2(float x) { return __builtin_amdgcn_exp2f(x); }
DI float wave_sum(float v) {
#pragma unroll
    for (int d = 32; d >= 1; d >>= 1) v += __shfl_xor(v, d);
    return v;
}
DI f32x16 zero16() { f32x16 z;
#pragma unroll
    for (int i = 0; i < 16; ++i) z[i] = 0.f; return z; }
DI bf16x8 pack8(const f32x16& x, int s) {
    u32x4 p; p[0] = pk2(x[8 * s], x[8 * s + 1]); p[1] = pk2(x[8 * s + 2], x[8 * s + 3]); p[2] = pk2(x[8 * s + 4], x[8 * s + 5]); p[3] = pk2(x[8 * s + 6], x[8 * s + 7]);
    return __builtin_bit_cast(bf16x8, p);
}

struct Epi {
    static constexpr bool PERM = false, AFTER_DRAIN = false;
    int mode;
    bf16_t* O; int ldo; int ropelim;
    const float* ropec; const float* ropes;
    float* G; const float* gate_b;
    float* X; const float* res_lat; const float* res_ctx; const float* gate;
    const float* ssq_in; const float* sbias;
    int sb_ld;
    bf16_t* Hout; const float* hgain; float* ssq_out;
    const float* cw; const float* cb; bf16_t* ACT; float* EDGE;
    __device__ __forceinline__ void operator()(const f32x4 (&acc)[2][2][4][2], const pg8::Unit& u, int wr, int wc, int fr, int fq) const {
        const int row0 = u.pm * 256 + wr * 64 + fr, col0 = u.pn * 256 + wc * 32 + 4 * fq;
#ifdef EPI_ONLY
        if (EPI_ONLY == 2) {
#else
        if (mode == 2) {
#endif
            const int ub = u.pm < 64 ? (u.pm >> 3) : 8;
            const float* gp = gate + (size_t)ub * 6144;
            f32x4 gv[2][2], hg[2][2];
#pragma unroll
            for (int bj = 0; bj < 2; ++bj)
#pragma unroll
                for (int n = 0; n < 2; ++n) {
                    const int c = col0 + bj * 128 + n * 16;
                    gv[bj][n] = *(const f32x4*)(gp + c);
                    hg[bj][n] = *(const f32x4*)(hgain + (size_t)ub * 1024 + c);
                }
#pragma unroll
            for (int ai = 0; ai < 2; ++ai)
#pragma unroll
                for (int mp = 0; mp < 2; ++mp) {
                    f32x4 rv[2][2][2];
#pragma unroll
                    for (int mm = 0; mm < 2; ++mm) {
                        const int r = row0 + ai * 128 + (2 * mp + mm) * 16;
                        const float* rp = r < MLAT ? res_lat + (size_t)r * DM : res_ctx + (size_t)(r - MLAT) * DM;
#pragma unroll
                        for (int bj = 0; bj < 2; ++bj)
#pragma unroll
                            for (int n = 0; n < 2; ++n) rv[mm][bj][n] = *(const f32x4*)(rp + col0 + bj * 128 + n * 16);
                    }
#pragma unroll
                    for (int mm = 0; mm < 2; ++mm) {
                        const int m = 2 * mp + mm, r = row0 + ai * 128 + m * 16;
                        float* xp = X + (size_t)r * DM;
                        float ss = 0.f;
#pragma unroll
                        for (int bj = 0; bj < 2; ++bj)
#pragma unroll
                            for (int n = 0; n < 2; ++n) {
                                const int c = col0 + bj * 128 + n * 16;
                                const f32x4 xn = rv[mm][bj][n] + gv[bj][n] * acc[ai][bj][m][n];
                                *(f32x4*)(xp + c) = xn;
                                if (Hout) {
                                    ss += xn[0] * xn[0] + xn[1] * xn[1] + xn[2] * xn[2] + xn[3] * xn[3];
                                    const f32x4 hv = xn * hg[bj][n];
                                    u32x2 p; p[0] = pk2(hv[0], hv[1]); p[1] = pk2(hv[2], hv[3]);
                                    *(u32x2*)(Hout + (size_t)r * DM + c) = p;
                                }
                            }
                        if (Hout) {
                            ss += __shfl_xor(ss, 16); ss += __shfl_xor(ss, 32);
                            if (fq == 0) atomicAdd(ssq_out + r, ss);
                        }
                    }
                }
#ifdef EPI_ONLY
        } else if (EPI_ONLY == 1) {
#else
        } else if (mode == 1) {
#endif
            const float sc = u.pn < 2 ? 0.125f : 1.0f;
            const f32x4 gbv[2] = {*(const f32x4*)(gate_b + 4 * fq), *(const f32x4*)(gate_b + 16 + 4 * fq)};
            const int ub = u.pm < 64 ? (u.pm >> 3) : 8;
            f32x4 sbv[2][2];
#pragma unroll
            for (int bj = 0; bj < 2; ++bj)
#pragma unroll
                for (int n = 0; n < 2; ++n) sbv[bj][n] = *(const f32x4*)(sbias + (size_t)ub * sb_ld + col0 + bj * 128 + n * 16);
            float rsv[2][4];
#pragma unroll
            for (int ai = 0; ai < 2; ++ai)
#pragma unroll
                for (int m = 0; m < 4; ++m) rsv[ai][m] = rsqrtf(ssq_in[row0 + ai * 128 + m * 16] * (1.0f / 1024.0f) + 1e-6f);
#pragma unroll
            for (int ai = 0; ai < 2; ++ai)
#pragma unroll
                for (int m = 0; m < 4; ++m) {
                    const int r = row0 + ai * 128 + m * 16;
                    const float rs = rsv[ai][m];
                    if (u.pn == 12) {
                        if (wc == 0) {
#pragma unroll
                            for (int n = 0; n < 2; ++n) {
                                const int lc = n * 16 + 4 * fq;
                                *(f32x4*)(G + (size_t)r * 32 + lc) = acc[ai][0][m][n] * rs + sbv[0][n] + gbv[n];
                            }
                        }
                    } else {
                        bf16_t* op = O + (size_t)r * ldo;
#pragma unroll
                        for (int bj = 0; bj < 2; ++bj)
#pragma unroll
                            for (int n = 0; n < 2; ++n) {
                                const f32x4 v = (acc[ai][bj][m][n] * rs + sbv[bj][n]) * sc;
                                u32x2 p; p[0] = pk2(v[0], v[1]); p[1] = pk2(v[2], v[3]);
                                *(u32x2*)(op + col0 + bj * 128 + n * 16) = p;
                            }
                    }
                }
        } else if (mode == 4) {
            const int ub = u.pm < 64 ? (u.pm >> 3) : 8;
            const int ch0 = u.pn * 128 + wc * 32 + 4 * fq;
            const __amdgpu_buffer_rsrc_t ersrc = __builtin_amdgcn_make_buffer_rsrc((void*)EDGE, 0, 288 * 4 * 2 * FFN * 4, 0x00020000);
            LAS float* cst = (LAS float*)(unsigned)(131072 + 1024 + (wr * 4 + wc) * 1280);
            {
                const int ln = fr + 16 * fq, hv = ln >> 5, c = ln & 31;
                const float* cwp = cw + u.pn * 128 + wc * 32; const float* cbp = cb + u.pn * 128 + wc * 32; const float* sbp = sbias + (size_t)ub * sb_ld + u.pn * 256 + wc * 32;
                const float v01 = cwp[hv * 2 * FFN + c];
                const float v23 = cwp[(hv ? FFN : 2 * 2 * FFN) + c];
                const float v45 = cwp[(hv ? 2 * 2 * FFN + FFN : 2 * FFN + FFN) + c];
                const float v67 = cbp[hv * FFN + c];
                const float v89 = sbp[hv * 128 + c];
                cst[ln] = v01; cst[64 + ln] = v23; cst[128 + ln] = v45; cst[192 + ln] = v67; cst[256 + ln] = v89;
            }
            float rsa[2][4];
#pragma unroll
            for (int ai = 0; ai < 2; ++ai)
#pragma unroll
                for (int m = 0; m < 4; ++m) rsa[ai][m] = rsqrtf(ssq_in[row0 + ai * 128 + m * 16] * (1.0f / 1024.0f) + 1e-6f);
#pragma unroll
            for (int n = 0; n < 2; ++n)
#pragma unroll
                for (int jp = 0; jp < 2; ++jp) {
                    __builtin_amdgcn_sched_barrier(0);
                    const int ch = ch0 + 16 * n + 2 * jp;
                    const int lc = 16 * n + 4 * fq + 2 * jp;
                    f32x2 wa[3], wg[3];
#pragma unroll
                    for (int j = 0; j < 3; ++j) { wa[j] = *(const LAS f32x2*)(cst + j * 32 + lc); wg[j] = *(const LAS f32x2*)(cst + (3 + j) * 32 + lc); }
                    const f32x2 ba = *(const LAS f32x2*)(cst + 6 * 32 + lc), bg = *(const LAS f32x2*)(cst + 7 * 32 + lc);
                    const f32x2 sa = *(const LAS f32x2*)(cst + 8 * 32 + lc), sg = *(const LAS f32x2*)(cst + 9 * 32 + lc);
#pragma unroll
                    for (int ai = 0; ai < 2; ++ai) {
                        const int seg = (row0 + ai * 128) >> 6;
                        const unsigned eo0 = fr < 2 ? (unsigned)(((seg * 4 + fr) * 2 * FFN + ch) * 4) : 0xf0000000u, eo3 = fr >= 14 ? (unsigned)(((seg * 4 + fr - 12) * 2 * FFN + ch) * 4) : 0xf0000000u;
                        float y[4][2], e0[4];
#pragma unroll
                        for (int jj = 0; jj < 2; ++jj) {
                            const int j = 2 * jp + jj;
                            float xa[4], xg[4];
#pragma unroll
                            for (int m = 0; m < 4; ++m) { xa[m] = acc[ai][0][m][n][j] * rsa[ai][m] + sa[jj]; xg[m] = acc[ai][1][m][n][j] * rsa[ai][m] + sg[jj]; }
#pragma unroll
                            for (int m = 0; m < 4; ++m) {
                                const int oa = m > 0 ? __builtin_amdgcn_mov_dpp(__builtin_bit_cast(int, xa[m > 0 ? m - 1 : 0]), 0x121, 0xf, 0xf, false) : 0;
                                const int og = m > 0 ? __builtin_amdgcn_mov_dpp(__builtin_bit_cast(int, xg[m > 0 ? m - 1 : 0]), 0x121, 0xf, 0xf, false) : 0;
                                const float pa = __builtin_bit_cast(float, __builtin_amdgcn_update_dpp(oa, __builtin_bit_cast(int, xa[m]), 0x111, 0xf, 0xf, false));
                                const float pg = __builtin_bit_cast(float, __builtin_amdgcn_update_dpp(og, __builtin_bit_cast(int, xg[m]), 0x111, 0xf, 0xf, false));
                                const int qa = m < 3 ? __builtin_amdgcn_mov_dpp(__builtin_bit_cast(int, xa[m < 3 ? m + 1 : 3]), 0x12f, 0xf, 0xf, false) : 0;
                                const int qg = m < 3 ? __builtin_amdgcn_mov_dpp(__builtin_bit_cast(int, xg[m < 3 ? m + 1 : 3]), 0x12f, 0xf, 0xf, false) : 0;
                                const float na = __builtin_bit_cast(float, __builtin_amdgcn_update_dpp(qa, __builtin_bit_cast(int, xa[m]), 0x101, 0xf, 0xf, false));
                                const float ng = __builtin_bit_cast(float, __builtin_amdgcn_update_dpp(qg, __builtin_bit_cast(int, xg[m]), 0x101, 0xf, 0xf, false));
                                const float av = ba[jj] + wa[0][jj] * pa + wa[1][jj] * xa[m] + wa[2][jj] * na;
                                const float gv = bg[jj] + wg[0][jj] * pg + wg[1][jj] * xg[m] + wg[2][jj] * ng;
                                y[m][jj] = av * gv * __builtin_amdgcn_rcpf(1.f + __expf(-gv));
                            }
                            if (jj == 0) { e0[0] = xa[0]; e0[1] = xg[0]; e0[2] = xa[3]; e0[3] = xg[3]; }
                            else {
                                u32x2 v;
                                v[0] = __builtin_bit_cast(unsigned, e0[0]); v[1] = __builtin_bit_cast(unsigned, xa[0]); __builtin_amdgcn_raw_buffer_store_b64(v, ersrc, (int)eo0, 0, 0);
                                v[0] = __builtin_bit_cast(unsigned, e0[1]); v[1] = __builtin_bit_cast(unsigned, xg[0]); __builtin_amdgcn_raw_buffer_store_b64(v, ersrc, (int)(eo0 + FFN * 4), 0, 0);
                                v[0] = __builtin_bit_cast(unsigned, e0[2]); v[1] = __builtin_bit_cast(unsigned, xa[3]); __builtin_amdgcn_raw_buffer_store_b64(v, ersrc, (int)eo3, 0, 0);
                                v[0] = __builtin_bit_cast(unsigned, e0[3]); v[1] = __builtin_bit_cast(unsigned, xg[3]); __builtin_amdgcn_raw_buffer_store_b64(v, ersrc, (int)(eo3 + FFN * 4), 0, 0);
                            }
                        }
#pragma unroll
                        for (int m = 0; m < 4; ++m) {
                            const int r = row0 + ai * 128 + m * 16;
                            *(unsigned*)(ACT + (size_t)r * FFN + ch) = pk2(y[m][0], y[m][1]);
                        }
                    }
                }
        } else if (mode == 3) {
#pragma unroll
            for (int ai = 0; ai < 2; ++ai)
#pragma unroll
                for (int m = 0; m < 4; ++m) {
                    bf16_t* op = O + (size_t)(row0 + ai * 128 + m * 16) * ldo;
#pragma unroll
                    for (int bj = 0; bj < 2; ++bj)
#pragma unroll
                        for (int n = 0; n < 2; ++n) {
                            const f32x4 v = acc[ai][bj][m][n];
                            u32x2 p; p[0] = pk2(v[0], v[1]); p[1] = pk2(v[2], v[3]);
                            *(u32x2*)(op + col0 + bj * 128 + n * 16) = p;
                        }
                }
        } else {
            const bool tile_rope = (u.pn * 256) < ropelim;
            const LAS float* ropeL = (const LAS float*)(unsigned)(131072 + 1024 + 10240);
            const int ub = u.pm < 64 ? (u.pm >> 3) : 8;
            f32x4 sbv[2][2];
#pragma unroll
            for (int bj = 0; bj < 2; ++bj)
#pragma unroll
                for (int n = 0; n < 2; ++n) sbv[bj][n] = *(const f32x4*)(sbias + (size_t)ub * sb_ld + col0 + bj * 128 + n * 16);
            float rsv[2][4];
#pragma unroll
            for (int ai = 0; ai < 2; ++ai)
#pragma unroll
                for (int m = 0; m < 4; ++m) rsv[ai][m] = rsqrtf(ssq_in[row0 + ai * 128 + m * 16] * (1.0f / 1024.0f) + 1e-6f);
#pragma unroll
            for (int ai = 0; ai < 2; ++ai)
#pragma unroll
                for (int m = 0; m < 4; ++m) {
                    const int r = row0 + ai * 128 + m * 16;
                    const float rs = rsv[ai][m];
                    bf16_t* op = O + (size_t)r * ldo;
                    if (tile_rope && r < MLAT) {
                        const int s = r & 2047, pos = (wc & 1) ? (s & 63) : (s >> 6);
                        const f32x4 cs = *(const LAS f32x4*)(ropeL + pos * 16 + 4 * fq), sn = *(const LAS f32x4*)(ropeL + 1024 + pos * 16 + 4 * fq);
#pragma unroll
                        for (int bj = 0; bj < 2; ++bj) {
                            const f32x4 x1 = acc[ai][bj][m][0] * rs + sbv[bj][0], x2 = acc[ai][bj][m][1] * rs + sbv[bj][1];
                            const f32x4 y1 = x1 * cs - x2 * sn, y2 = x2 * cs + x1 * sn;
                            u32x2 p; p[0] = pk2(y1[0], y1[1]); p[1] = pk2(y1[2], y1[3]);
                            *(u32x2*)(op + col0 + bj * 128) = p;
                            p[0] = pk2(y2[0], y2[1]); p[1] = pk2(y2[2], y2[3]);
                            *(u32x2*)(op + col0 + bj * 128 + 16) = p;
                        }
                    } else {
#pragma unroll
                        for (int bj = 0; bj < 2; ++bj)
#pragma unroll
                            for (int n = 0; n < 2; ++n) {
                                const f32x4 v = acc[ai][bj][m][n] * rs + sbv[bj][n];
                                u32x2 p; p[0] = pk2(v[0], v[1]); p[1] = pk2(v[2], v[3]);
                                *(u32x2*)(op + col0 + bj * 128 + n * 16) = p;
                            }
                    }
                }
        }
    }
};

DI void run_gemm(char* shm, const bf16_t* A, const bf16_t* Bt, int M, int N, int K, const Epi& E) {
    pg8::Gemm g; g.A = A; g.Bt = Bt; g.M = M; g.N = N; g.K = K;
    pg8::StaticOrder S; S.init(M, N, (int)gridDim.x, (int)blockIdx.x);
#ifndef NO_GEMM
    pg8::gemm_phase<Epi, pg8::StaticOrder>((LAS unsigned char*)shm, g, S, E);
#endif
    __syncthreads();
}

DI void phase_prologue(const Args& a, char* shm) {
    float* sc = (float*)shm;
    float* red = sc + 9 * 1024;
    const int tid = otid();
    for (int i = tid; i < 9 * 1024; i += 512) { const int r = i >> 10, k = i & 1023; const float v = r < 8 ? a.in[1][r * 1024 + k] : a.in[3][k]; sc[i] = v / (1.f + __expf(-v)); }
    __syncthreads();
    float* mod = (float*)(a.ws + WS_MOD);
    for (int item = blockIdx.x; item < 193; item += gridDim.x) {
        if (item < 192) {
            const int l = item / 48, j0 = (item % 48) * 128, col = tid & 127, kq = tid >> 7;
            const float* W = a.in[lbase(l)] + j0 + col;
            float acc[9];
#pragma unroll
            for (int r = 0; r < 9; ++r) acc[r] = 0.f;
            for (int k = kq * 256; k < kq * 256 + 256; k += 32) {
                float w[32];
#pragma unroll
                for (int j = 0; j < 32; ++j) w[j] = __builtin_nontemporal_load(W + (size_t)(k + j) * 6144);
#pragma unroll
                for (int j = 0; j < 32; j += 4)
#pragma unroll
                    for (int r = 0; r < 9; ++r) { const f32x4 s = *(const f32x4*)(sc + r * 1024 + k + j); acc[r] += s[0] * w[j] + s[1] * w[j + 1] + s[2] * w[j + 2] + s[3] * w[j + 3]; }
            }
#pragma unroll
            for (int r = 0; r < 9; ++r) red[(kq * 9 + r) * 128 + col] = acc[r];
            __syncthreads();
            for (int i = tid; i < 9 * 128; i += 512) {
                const int r = i >> 7, cc = i & 127;
                const float s = red[r * 128 + cc] + red[(9 + r) * 128 + cc] + red[(18 + r) * 128 + cc] + red[(27 + r) * 128 + cc];
                mod[(size_t)(l * 9 + r) * 6144 + j0 + cc] = s + a.in[lbase(l) + 1][j0 + cc];
            }
            __syncthreads();
        } else {
            float* ropec = (float*)(a.ws + WS_ROPE); float* ropes = ropec + 1024; float* lam = ropec + 2048;
            for (int i = tid; i < 1024; i += 512) {
                const int pos = i >> 4, f = i & 15;
                const float inv = powf(10000.0f, -(float)f / 16.0f), ang = (float)pos * inv;
                ropec[i] = cosf(ang); ropes[i] = sinf(ang);
            }
            if (tid < 2) {
                const int l = tid == 0 ? 0 : 3, bs = lbase(l);
                float s1 = 0.f, s2 = 0.f;
                for (int k = 0; k < 64; ++k) { s1 += a.in[bs + 4][k] * a.in[bs + 5][k]; s2 += a.in[bs + 6][k] * a.in[bs + 7][k]; }
                const float lam_init = 0.8f - 0.6f * expf(-0.3f * (float)l);
                lam[tid * 2] = expf(s1) - expf(s2) + lam_init; lam[tid * 2 + 1] = lam_init;
            }
        }
    }
}

DI void convert_st(const float* W, int K, int N, bf16_t* Wt, int kt, int nt4, int upperm, float* T, float* sh, const float* shift, float* sb, int sb_ld) {
    const int tid = otid(), k0 = kt * 64, n0 = nt4 * 256;
    __syncthreads();
#pragma unroll
    for (int it = 0; it < 8; ++it) {
        const int k = it * 8 + (tid >> 6), n4 = (tid & 63) * 4;
        f32x4 v = {0.f, 0.f, 0.f, 0.f};
        if (n0 + n4 < N) v = *(const f32x4*)(W + (size_t)(k0 + k) * N + n0 + n4);
        *(f32x4*)(T + k * 260 + n4) = v;
    }
    if (sb) { for (int i = tid; i < 576; i += 512) sh[i] = shift[(size_t)(i >> 6) * 6144 + k0 + (i & 63)]; }
    __syncthreads();
    const int n = tid >> 1, kh = tid & 1, nn = n0 + n;
    int row = nn;
    if (upperm) { const int f = nn < FFN ? nn : nn - FFN; row = 256 * (f >> 7) + (nn < FFN ? 0 : 128) + (f & 127); }
    float v[32];
#pragma unroll
    for (int i = 0; i < 32; ++i) v[i] = T[(32 * kh + i) * 260 + n];
    bf16_t* dst = Wt + (size_t)row * K + k0 + 32 * kh;
#pragma unroll
    for (int j = 0; j < 4; ++j) {
        u32x4 p; p[0] = pk2(v[8 * j], v[8 * j + 1]); p[1] = pk2(v[8 * j + 2], v[8 * j + 3]); p[2] = pk2(v[8 * j + 4], v[8 * j + 5]); p[3] = pk2(v[8 * j + 6], v[8 * j + 7]);
        *(u32x4*)(dst + 8 * j) = p;
    }
    if (sb) {
#pragma unroll
        for (int rb = 0; rb < 9; ++rb) {
            float p = 0.f;
#pragma unroll
            for (int i = 0; i < 32; i += 4) { const f32x4 s4 = *(const f32x4*)(sh + rb * 64 + 32 * kh + i); p += s4[0] * v[i] + s4[1] * v[i + 1] + s4[2] * v[i + 2] + s4[3] * v[i + 3]; }
            p += __shfl_xor(p, 1);
            if (kh == 0 && nn < N) atomicAdd(sb + (size_t)rb * sb_ld + row, p);
        }
    }
}
DI void phase_convert(const Args& a, char* shm, int l, int which, int idx, int nstride) {
    const int kind = l % 3, bs = lbase(l), nin = nin_of(kind), nint = (nin + 255) >> 8;
    const int n_in = (which & 1) ? nint * 16 : 0, n_out = (which & 2) ? 64 : 0, n_up = (which & 4) ? 22 * 16 : 0, n_down = (which & 8) ? 4 * 44 : 0;
    const int total = n_in + n_out + n_up + n_down;
    unsigned char* wb = a.ws + WS_W;
    float* T = (float*)shm; float* sh = T + 64 * 260;
    const float* mod_l = (const float*)(a.ws + WS_MOD) + (size_t)l * 9 * 6144;
    float* sb_in = (float*)(a.ws + WS_SB) + (size_t)l * SB_LAYER; float* sb_up = sb_in + 9 * SB_IN_LD;
    for (int item = idx; item < total; item += nstride) {
        int it = item;
        if (it < n_in) { convert_st(a.in[bs + 3], 1024, nin, (bf16_t*)(wb + WOFF_IN), it & 15, it >> 4, 0, T, sh, mod_l, sb_in, SB_IN_LD); continue; }
        it -= n_in;
        if (it < n_out) { convert_st(a.in[bs + off_wout(kind)], 1024, 1024, (bf16_t*)(wb + WOFF_OUT), it & 15, it >> 4, 0, T, sh, nullptr, nullptr, 0); continue; }
        it -= n_out;
        if (it < n_up) { convert_st(a.in[bs + off_wout(kind) + 2], 1024, 2 * FFN, (bf16_t*)(wb + WOFF_UP), it & 15, it >> 4, 1, T, sh, mod_l + 3072, sb_up, SB_UP_LD); continue; }
        it -= n_up;
        convert_st(a.in[bs + off_wout(kind) + 5], FFN, 1024, (bf16_t*)(wb + WOFF_DOWN), it % 44, it / 44, 0, T, sh, nullptr, nullptr, 0);
    }
    __syncthreads();
}

DI void phase_prenorm(const float* Xl, const float* Xc, const float* g, const float* mod_l, int scoff, bf16_t* H, float* ssq, int nrows) {
    const int lane = otid() & 63, wid = otid() >> 6, rstride = gridDim.x * 8;
    for (int row0 = blockIdx.x * 8 + wid; row0 < nrows; row0 += 4 * rstride) {
        f32x4 v[4][4];
#pragma unroll
        for (int k = 0; k < 4; ++k) {
            const int rk = row0 + k * rstride, row = rk < nrows ? rk : row0;
            const float* xr = row < MLAT ? Xl + (size_t)row * DM : Xc + (size_t)(row - MLAT) * DM;
#pragma unroll
            for (int i = 0; i < 4; ++i) v[k][i] = *(const f32x4*)(xr + i * 256 + lane * 4);
        }
#pragma unroll
        for (int k = 0; k < 4; ++k) {
            const int row = row0 + k * rstride;
            if (row < nrows) {
                const float* mp = mod_l + (size_t)(row < MLAT ? (row >> 11) : 8) * 6144;
                float ss = 0.f;
#pragma unroll
                for (int i = 0; i < 4; ++i) ss += v[k][i][0] * v[k][i][0] + v[k][i][1] * v[k][i][1] + v[k][i][2] * v[k][i][2] + v[k][i][3] * v[k][i][3];
                ss = wave_sum(ss);
                if (lane == 0) ssq[row] = ss;
#pragma unroll
                for (int i = 0; i < 4; ++i) {
                    const int c = i * 256 + lane * 4;
                    const f32x4 gg = *(const f32x4*)(g + c), sc = *(const f32x4*)(mp + scoff + c);
                    const f32x4 y = (v[k][i] * gg) * (sc + 1.0f);
                    u32x2 p; p[0] = pk2(y[0], y[1]); p[1] = pk2(y[2], y[3]);
                    *(u32x2*)(H + (size_t)row * DM + c) = p;
                }
            }
        }
    }
}
DI void phase_final_norm(const float* X, const float* g, float* out) {
    const int lane = otid() & 63, wid = otid() >> 6, rstride = gridDim.x * 8;
    f32x4 gg[4];
#pragma unroll
    for (int i = 0; i < 4; ++i) gg[i] = *(const f32x4*)(g + i * 256 + lane * 4);
    for (int row0 = blockIdx.x * 8 + wid; row0 < MLAT; row0 += 4 * rstride) {
        f32x4 v[4][4];
#pragma unroll
        for (int k = 0; k < 4; ++k) {
            const int rk = row0 + k * rstride, row = rk < MLAT ? rk : row0;
#pragma unroll
            for (int i = 0; i < 4; ++i) v[k][i] = *(const f32x4*)(X + (size_t)row * DM + i * 256 + lane * 4);
        }
#pragma unroll
        for (int k = 0; k < 4; ++k) {
            const int row = row0 + k * rstride;
            if (row < MLAT) {
                float ss = 0.f;
#pragma unroll
                for (int i = 0; i < 4; ++i) ss += v[k][i][0] * v[k][i][0] + v[k][i][1] * v[k][i][1] + v[k][i][2] * v[k][i][2] + v[k][i][3] * v[k][i][3];
                ss = wave_sum(ss);
                const float rstd = rsqrtf(ss * (1.0f / 1024.0f) + 1e-6f);
#pragma unroll
                for (int i = 0; i < 4; ++i) *(f32x4*)(out + (size_t)row * DM + i * 256 + lane * 4) = v[k][i] * rstd * gg[i];
            }
        }
    }
}

struct AttnP { const bf16_t* QKV; int pitch, qrow, qcol, kcol0, kslot, vcol, ntile, ctxrow0, latrow0, qpos, kpos0; };
constexpr float C2 = 0.125f * 1.4426950408889634f;

template <int NKT, int NDVB, bool SWA>
DI void attn_core(char* shm, const AttnP& P, f32x16 (&O)[NDVB], float& mrow, float& lrow) {
    constexpr int KB = 64 * 144, VB = 32 * NDVB * 144, STAGE = NKT * KB + VB, NVL = NDVB / 2;
    const int tid = otid(), lane = tid & 63, l31 = lane & 31, hh = lane >> 5;
    bf16x8 qf[4];
#pragma unroll
    for (int ks = 0; ks < 4; ++ks) qf[ks] = *(const bf16x8*)(P.QKV + (size_t)(P.qrow + l31) * P.pitch + P.qcol + ks * 16 + hh * 8);
    mrow = -1e30f; lrow = 0.f;
#pragma unroll
    for (int d = 0; d < NDVB; ++d) O[d] = zero16();
    const int kkey = tid >> 3, kch = tid & 7, vkey = tid & 63, vch0 = tid >> 6;
    const int vpos = (vkey & ~12) | ((vkey & 4) << 1) | ((vkey & 8) >> 1);
    u32x4 kreg[NKT], vreg[NVL];
#define ATT_GLOAD(t) do { const int r0_ = (t) < 4 ? P.ctxrow0 + 64 * (t) : P.latrow0 + 64 * ((t) - 4); \
        _Pragma("unroll") for (int c = 0; c < NKT; ++c) kreg[c] = *(const u32x4*)(P.QKV + (size_t)(r0_ + kkey) * P.pitch + P.kcol0 + c * 64 + kch * 8); \
        _Pragma("unroll") for (int j = 0; j < NVL; ++j) vreg[j] = *(const u32x4*)(P.QKV + (size_t)(r0_ + vkey) * P.pitch + P.vcol + (vch0 + 8 * j) * 8); } while (0)
    ATT_GLOAD(0);
    for (int t = 0; t < P.ntile; ++t) {
        char* base = shm + (t & 1) * STAGE;
#pragma unroll
        for (int c = 0; c < NKT; ++c) *(u32x4*)(base + c * KB + kkey * 144 + kch * 16) = kreg[c];
#pragma unroll
        for (int j = 0; j < NVL; ++j) {
            char* vb = base + NKT * KB + ((vch0 + 8 * j) * 8) * 144 + vpos * 2;
#pragma unroll
            for (int i = 0; i < 8; ++i) *(unsigned short*)(vb + i * 144) = (unsigned short)((vreg[j][i >> 1] >> (16 * (i & 1))) & 0xffffu);
        }
        __syncthreads();
        if (t + 1 < P.ntile) ATT_GLOAD(t + 1);
        const char* kbase = base + P.kslot * KB;
        f32x16 S[2]; S[0] = zero16(); S[1] = zero16();
        {
            bf16x8 kf[2][4];
#pragma unroll
            for (int kb = 0; kb < 2; ++kb)
#pragma unroll
                for (int ks = 0; ks < 4; ++ks) kf[kb][ks] = *(const bf16x8*)(kbase + (kb * 32 + l31) * 144 + (ks * 16 + hh * 8) * 2);
            __builtin_amdgcn_sched_barrier(0);
            __builtin_amdgcn_s_setprio(1);
#pragma unroll
            for (int ks = 0; ks < 4; ++ks)
#pragma unroll
                for (int kb = 0; kb < 2; ++kb) S[kb] = mfma32(kf[kb][ks], qf[ks], S[kb]);
            __builtin_amdgcn_s_setprio(0);
        }
        bool need_mask = false;
        if (SWA) { if (t >= 4) { const int k0 = P.kpos0 + 64 * (t - 4); need_mask = (P.qpos + 31 - k0 > 128) || (k0 + 63 - P.qpos > 128); } }
        float mx = -1e30f;
#pragma unroll
        for (int kb = 0; kb < 2; ++kb)
#pragma unroll
            for (int i = 0; i < 16; ++i) {
                if (SWA) { if (need_mask) { const int dd = (P.qpos + l31) - (P.kpos0 + 64 * (t - 4) + kb * 32 + crow(i, hh)); if (dd > 128 || dd < -128) S[kb][i] = -1e30f; } }
                mx = fmaxf(mx, S[kb][i]);
            }
        mx = fmaxf(mx, __shfl_xor(mx, 32));
        const float mnew = fmaxf(mrow, mx);
        const float mc = mnew * C2;
        float rs = 0.f;
#pragma unroll
        for (int kb = 0; kb < 2; ++kb)
#pragma unroll
            for (int i = 0; i < 16; ++i) { const float p = fexp2(__builtin_fmaf(S[kb][i], C2, -mc)); S[kb][i] = p; rs += p; }
        rs += __shfl_xor(rs, 32);
        if (__any(mnew != mrow)) {
            const float alpha = fexp2((mrow - mnew) * C2);
            lrow *= alpha;
#pragma unroll
            for (int d = 0; d < NDVB; ++d) O[d] = O[d] * alpha;
        }
        mrow = mnew;
        lrow += rs;
        {
            bf16x8 vf[2][2][NDVB];
#pragma unroll
            for (int kb = 0; kb < 2; ++kb)
#pragma unroll
                for (int s = 0; s < 2; ++s)
#pragma unroll
                    for (int d = 0; d < NDVB; ++d) vf[kb][s][d] = *(const bf16x8*)(base + NKT * KB + (d * 32 + l31) * 144 + (kb * 32 + s * 16 + hh * 8) * 2);
            bf16x8 pf[2][2];
#pragma unroll
            for (int kb = 0; kb < 2; ++kb) { pf[kb][0] = pack8(S[kb], 0); pf[kb][1] = pack8(S[kb], 1); }
            __builtin_amdgcn_sched_barrier(0);
            __builtin_amdgcn_s_setprio(1);
#pragma unroll
            for (int kb = 0; kb < 2; ++kb)
#pragma unroll
                for (int s = 0; s < 2; ++s)
#pragma unroll
                    for (int d = 0; d < NDVB; ++d) O[d] = mfma32(vf[kb][s][d], pf[kb][s], O[d]);
            __builtin_amdgcn_s_setprio(0);
        }
    }
#undef ATT_GLOAD
    __syncthreads();
}

DI void phase_da(const Args& a, char* shm, int l, bool need_ctx) {
    const bf16_t* QKV = (const bf16_t*)(a.ws + WS_QKV);
    bf16_t* ATT = (bf16_t*)(a.ws + WS_ATT);
    const float* lamp = (const float*)(a.ws + WS_ROPE) + 2048 + (l == 0 ? 0 : 2);
    const float lam = lamp[0], lam_init = lamp[1];
    const float* subg = a.in[lbase(l) + 8];
    const int lane = otid() & 63, wid = otid() >> 6, l31 = lane & 31, hh = lane >> 5;
    const int comp = wid >> 2, wq = wid & 3;
    float* xch = (float*)shm;
    const int nitem = 1024 + (need_ctx ? 128 : 0);
    for (int item = blockIdx.x; item < nitem; item += gridDim.x) {
        AttnP P; P.QKV = QKV; P.pitch = 3072; P.qpos = 0; P.kpos0 = 0;
        int b, h;
        if (item < 1024) {
            const int xcd = item & 7, j = item >> 3, qb = j & 15, bh = (j >> 4) * 8 + xcd;
            b = bh >> 3; h = bh & 7;
            P.qrow = b * 2048 + qb * 128 + wq * 32; P.ntile = 36;
        } else {
            const int i2 = item - 1024, qb = i2 & 1; h = (i2 >> 1) & 7; b = i2 >> 4;
            P.qrow = MLAT + b * 256 + qb * 128 + wq * 32; P.ntile = 4;
        }
        P.ctxrow0 = MLAT + b * 256; P.latrow0 = b * 2048;
        P.qcol = h * 128 + comp * 64; P.kcol0 = 1024 + h * 128; P.kslot = comp; P.vcol = 2048 + h * 128;
        f32x16 O[4]; float mr, lr;
        attn_core<2, 4, false>(shm, P, O, mr, lr);
        if (comp == 1) {
            const float inv1 = lam / lr;
#pragma unroll
            for (int d = 0; d < 4; ++d)
#pragma unroll
                for (int i = 0; i < 16; ++i) xch[((wq * 4 + d) * 16 + i) * 64 + lane] = O[d][i] * inv1;
        }
        __syncthreads();
        if (comp == 0) {
            const float inv0 = 1.0f / lr;
            float ss = 0.f;
#pragma unroll
            for (int d = 0; d < 4; ++d)
#pragma unroll
                for (int i = 0; i < 16; ++i) { const float o = O[d][i] * inv0 - xch[((wq * 4 + d) * 16 + i) * 64 + lane]; O[d][i] = o; ss += o * o; }
            ss += __shfl_xor(ss, 32);
            const float rstd = rsqrtf(ss * (1.0f / 128.0f) + 1e-6f) * (1.0f - lam_init);
            bf16_t* op = ATT + (size_t)(P.qrow + l31) * DM + h * 128;
#pragma unroll
            for (int d = 0; d < 4; ++d)
#pragma unroll
                for (int ig = 0; ig < 4; ++ig) {
                    const int dv = 32 * d + 8 * ig + 4 * hh;
                    const f32x4 g4 = *(const f32x4*)(subg + dv);
                    u32x2 p; p[0] = pk2(O[d][4 * ig] * rstd * g4[0], O[d][4 * ig + 1] * rstd * g4[1]);
                    p[1] = pk2(O[d][4 * ig + 2] * rstd * g4[2], O[d][4 * ig + 3] * rstd * g4[3]);
                    *(u32x2*)(op + dv) = p;
                }
        }
        __syncthreads();
    }
}

DI void phase_swa(const Args& a, char* shm, int l, bool need_ctx) {
    const bf16_t* QKV = (const bf16_t*)(a.ws + WS_QKV);
    bf16_t* ATT = (bf16_t*)(a.ws + WS_ATT);
    const float* sink = a.in[lbase(l) + 4];
    const int lane = otid() & 63, wid = otid() >> 6, l31 = lane & 31, hh = lane >> 5;
    const int nitem = 1024 + (need_ctx ? 128 : 0);
    for (int item = blockIdx.x; item < nitem; item += gridDim.x) {
        AttnP P; P.QKV = QKV; P.pitch = 1536; P.kslot = 0;
        int b, kvh;
        if (item < 1024) {
            const int xcd = item & 7, j_ = item >> 3, qb = j_ & 31, grp = (j_ >> 5) * 8 + xcd;
            kvh = grp & 3; b = grp >> 2;
            const int q0 = qb * 64, ks = q0 - 128 < 0 ? 0 : q0 - 128, ke = q0 + 192 > 2048 ? 2048 : q0 + 192;
            P.ntile = 4 + ((ke - ks) >> 6); P.latrow0 = b * 2048 + ks; P.kpos0 = ks;
            P.qpos = q0 + (wid & 1) * 32; P.qrow = b * 2048 + P.qpos;
        } else {
            const int i2 = item - 1024, j = i2 & 3; kvh = (i2 >> 2) & 3; b = i2 >> 4;
            P.ntile = 4; P.latrow0 = 0; P.kpos0 = 0; P.qpos = 0;
            P.qrow = MLAT + b * 256 + j * 64 + (wid & 1) * 32;
        }
        const int head = kvh * 4 + (wid >> 1);
        P.ctxrow0 = MLAT + b * 256;
        P.qcol = head * 64; P.kcol0 = 1024 + kvh * 64; P.vcol = 1280 + kvh * 64;
        f32x16 O[2]; float mr, lr;
        attn_core<1, 2, true>(shm, P, O, mr, lr);
        const float ltot = lr + fexp2(sink[head] * 1.4426950408889634f - mr * C2);
        const float inv = 1.0f / ltot;
        bf16_t* op = ATT + (size_t)(P.qrow + l31) * DM + head * 64;
#pragma unroll
        for (int d = 0; d < 2; ++d)
#pragma unroll
            for (int ig = 0; ig < 4; ++ig) {
                const int dv = 32 * d + 8 * ig + 4 * hh;
                u32x2 p; p[0] = pk2(O[d][4 * ig] * inv, O[d][4 * ig + 1] * inv); p[1] = pk2(O[d][4 * ig + 2] * inv, O[d][4 * ig + 3] * inv);
                *(u32x2*)(op + dv) = p;
            }
    }
}

DI int ml_row(int b, int dir, int p) { return p < 256 ? MLAT + b * 256 + (dir ? 255 - p : p) : b * 2048 + (dir ? 2047 - (p - 256) : (p - 256)); }

DI void phase_mlstm(const Args& a, char* shm) {
    const bf16_t* QKV = (const bf16_t*)(a.ws + WS_QKV);
    const float* G = (const float*)(a.ws + WS_G);
    constexpr int pitch = 3328;
    float* sA = (float*)shm; float* sB = sA + 2304; float* sM = sB + 2304; float* sN = sM + 2304;
    char* Qs = shm + 32768; char* Ks = Qs + 9216; char* KgT = Ks + 9216; char* Vt = KgT + 9216; char* Cs = Vt + 18432;
    const int tid = otid(), lane = tid & 63, wid = tid >> 6, l31 = lane & 31, hh = lane >> 5;
    const int eb = wid >> 1, tb = wid & 1;
    for (int item = blockIdx.x; item < 128; item += gridDim.x) {
        const int b = item >> 4, h = (item >> 1) & 7, dir = item & 1;
        bf16_t* HD = (bf16_t*)(a.ws + (dir ? WS_HB : WS_HF));
        __syncthreads();
        for (int p = tid; p < 2304; p += 512) {
            const int row = ml_row(b, dir, p);
            const float ig = G[(size_t)row * 32 + (2 * dir) * 8 + h], fg = G[(size_t)row * 32 + (2 * dir + 1) * 8 + h];
            sA[p] = ig; sB[p] = fminf(fg, 0.f) - log1pf(expf(-fabsf(fg)));
        }
        for (int i = tid; i < 128 * 72 / 2; i += 512) ((unsigned*)Cs)[i] = 0u;
        if (tid < 64) sN[tid] = 0.f;
        __syncthreads();
        if (wid == 0) {
            const int p0 = lane * 36;
            float s = 0.f;
            for (int i = 0; i < 36; ++i) s += sB[p0 + i];
            float incl = s;
#pragma unroll
            for (int d = 1; d < 64; d <<= 1) { const float t = __shfl_up(incl, d); if (lane >= d) incl += t; }
            float run = incl - s, mxl = -3.0e38f;
            for (int i = 0; i < 36; ++i) { run += sB[p0 + i]; const float aa = sA[p0 + i] - run; sA[p0 + i] = aa; sM[p0 + i] = run; mxl = fmaxf(mxl, aa); }
            float inclm = mxl;
#pragma unroll
            for (int d = 1; d < 64; d <<= 1) { const float t = __shfl_up(inclm, d); if (lane >= d) inclm = fmaxf(inclm, t); }
            float offm = __shfl_up(inclm, 1); if (lane == 0) offm = 0.f;
            float runm = fmaxf(offm, 0.f);
            for (int i = 0; i < 36; ++i) { runm = fmaxf(runm, sA[p0 + i]); sB[p0 + i] = runm; sM[p0 + i] += runm; }
        }
        f32x16 Cacc = zero16(); float nacc = 0.f;
        const int qs_ = tid >> 3, qch = tid & 7, ss_ = tid & 63, sch = tid >> 6;
        const int spos = (ss_ & ~12) | ((ss_ & 4) << 1) | ((ss_ & 8) >> 1);
        u32x4 qreg, kreg, vreg[2];
#define ML_GLOAD(c) do { const int rq_ = ml_row(b, dir, 64 * (c) + qs_), rs_ = ml_row(b, dir, 64 * (c) + ss_); \
        qreg = *(const u32x4*)(QKV + (size_t)rq_ * pitch + h * 64 + qch * 8); \
        kreg = *(const u32x4*)(QKV + (size_t)rs_ * pitch + 512 + h * 64 + sch * 8); \
        vreg[0] = *(const u32x4*)(QKV + (size_t)rs_ * pitch + 1024 + h * 128 + sch * 8); \
        vreg[1] = *(const u32x4*)(QKV + (size_t)rs_ * pitch + 1024 + h * 128 + (sch + 8) * 8); } while (0)
        ML_GLOAD(0);
        __syncthreads();
        for (int c = 0; c < 36; ++c) {
            const int p0 = 64 * c;
            const float Aprev = c ? sB[p0 - 1] : 0.f, Aend = sB[p0 + 63], decay = __expf(Aprev - Aend);
            *(u32x4*)(Qs + qs_ * 144 + qch * 16) = qreg;
            *(u32x4*)(Ks + ss_ * 144 + sch * 16) = kreg;
            {
                const float gs = __expf(sA[p0 + ss_] - Aend);
#pragma unroll
                for (int i = 0; i < 8; ++i) {
                    const unsigned w = kreg[i >> 1];
                    const float kv = (i & 1) ? bfhi(w) : bflo(w);
                    *(unsigned short*)(KgT + (sch * 8 + i) * 144 + spos * 2) = (unsigned short)(pk2(kv * gs, 0.f) & 0xffffu);
                }
#pragma unroll
                for (int j = 0; j < 2; ++j)
#pragma unroll
                    for (int i = 0; i < 8; ++i)
                        *(unsigned short*)(Vt + ((sch + 8 * j) * 8 + i) * 144 + spos * 2) = (unsigned short)((vreg[j][i >> 1] >> (16 * (i & 1))) & 0xffffu);
            }
            __syncthreads();
            if (c + 1 < 36) ML_GLOAD(c + 1);
            const int t = 32 * tb + l31;
            const float At = sB[p0 + t], inter = __expf(Aprev - At);
            bf16x8 qf[4];
#pragma unroll
            for (int ks = 0; ks < 4; ++ks) qf[ks] = *(const bf16x8*)(Qs + t * 144 + (ks * 16 + hh * 8) * 2);
            f32x16 S[2]; S[0] = zero16(); S[1] = zero16();
#pragma unroll
            for (int sb = 0; sb < 2; ++sb)
                if (sb <= tb) {
#pragma unroll
                    for (int ks = 0; ks < 4; ++ks) { const bf16x8 af = *(const bf16x8*)(Ks + (sb * 32 + l31) * 144 + (ks * 16 + hh * 8) * 2); S[sb] = mfma32(af, qf[ks], S[sb]); }
                }
            float colsum = 0.f;
#pragma unroll
            for (int sb = 0; sb < 2; ++sb)
                if (sb <= tb) {
#pragma unroll
                    for (int iq = 0; iq < 4; ++iq) {
                        const int s0 = 32 * sb + 8 * iq + 4 * hh;
                        const f32x4 a4 = *(const f32x4*)(sA + p0 + s0);
#pragma unroll
                        for (int j = 0; j < 4; ++j) {
                            const float w = (s0 + j <= t) ? __expf(a4[j] - At) : 0.f;
                            const float pv = S[sb][4 * iq + j] * w; S[sb][4 * iq + j] = pv; colsum += pv;
                        }
                    }
                }
            colsum += __shfl_xor(colsum, 32);
            float qn = 0.f;
#pragma unroll
            for (int j = 0; j < 4; ++j) {
                const u32x4 q8 = *(const u32x4*)(Qs + t * 144 + (32 * hh + 8 * j) * 2);
                const f32x4 n0 = *(const f32x4*)(sN + 32 * hh + 8 * j), n1 = *(const f32x4*)(sN + 32 * hh + 8 * j + 4);
                qn += bflo(q8[0]) * n0[0] + bfhi(q8[0]) * n0[1] + bflo(q8[1]) * n0[2] + bfhi(q8[1]) * n0[3] + bflo(q8[2]) * n1[0] + bfhi(q8[2]) * n1[1] + bflo(q8[3]) * n1[2] + bfhi(q8[3]) * n1[3];
            }
            qn += __shfl_xor(qn, 32);
            const float den = inter * qn + colsum, mt = sM[p0 + t];
            const float rinv = 1.0f / fmaxf(fabsf(den), __expf(-mt));
            bf16x8 vf[4];
#pragma unroll
            for (int ks = 0; ks < 4; ++ks) vf[ks] = *(const bf16x8*)(Vt + (32 * eb + l31) * 144 + (ks * 16 + hh * 8) * 2);
            f32x16 acc1 = zero16(), acc2 = zero16();
#pragma unroll
            for (int ks = 0; ks < 4; ++ks) { const bf16x8 cf = *(const bf16x8*)(Cs + (32 * eb + l31) * 144 + (ks * 16 + hh * 8) * 2); acc1 = mfma32(cf, qf[ks], acc1); }
#pragma unroll
            for (int sb = 0; sb < 2; ++sb)
                if (sb <= tb) {
#pragma unroll
                    for (int s = 0; s < 2; ++s) acc2 = mfma32(vf[2 * sb + s], pack8(S[sb], s), acc2);
                }
            {
                bf16_t* op = HD + (size_t)ml_row(b, dir, p0 + t) * DM + h * 128 + 32 * eb;
#pragma unroll
                for (int ig = 0; ig < 4; ++ig) {
                    u32x2 p; p[0] = pk2((acc1[4 * ig] * inter + acc2[4 * ig]) * rinv, (acc1[4 * ig + 1] * inter + acc2[4 * ig + 1]) * rinv);
                    p[1] = pk2((acc1[4 * ig + 2] * inter + acc2[4 * ig + 2]) * rinv, (acc1[4 * ig + 3] * inter + acc2[4 * ig + 3]) * rinv);
                    *(u32x2*)(op + 8 * ig + 4 * hh) = p;
                }
            }
            Cacc = Cacc * decay;
#pragma unroll
            for (int ks = 0; ks < 4; ++ks) { const bf16x8 kg = *(const bf16x8*)(KgT + (32 * tb + l31) * 144 + (ks * 16 + hh * 8) * 2); Cacc = mfma32(vf[ks], kg, Cacc); }
            if (wid == 0) {
                float sum = 0.f;
#pragma unroll
                for (int j = 0; j < 8; ++j) { const u32x4 k8 = *(const u32x4*)(KgT + lane * 144 + j * 16); sum += bflo(k8[0]) + bfhi(k8[0]) + bflo(k8[1]) + bfhi(k8[1]) + bflo(k8[2]) + bfhi(k8[2]) + bflo(k8[3]) + bfhi(k8[3]); }
                nacc = nacc * decay + sum;
            }
            __syncthreads();
#pragma unroll
            for (int i = 0; i < 16; ++i) *(unsigned short*)(Cs + (32 * eb + crow(i, hh)) * 144 + (32 * tb + l31) * 2) = (unsigned short)(pk2(Cacc[i], 0.f) & 0xffffu);
            if (wid == 0) sN[lane] = nacc;
        }
#undef ML_GLOAD
    }
    __syncthreads();
}

DI void phase_ml_finish(const Args& a, int l, int nrows) {
    const bf16_t* HF = (const bf16_t*)(a.ws + WS_HF); const bf16_t* HB = (const bf16_t*)(a.ws + WS_HB);
    const bf16_t* QKV = (const bf16_t*)(a.ws + WS_QKV);
    bf16_t* ATT = (bf16_t*)(a.ws + WS_ATT);
    const float* ng = a.in[lbase(l) + 5];
    const int lane = otid() & 63, wid = otid() >> 6, rstride = gridDim.x * 8, c0 = lane * 16;
    f32x4 gq[4];
#pragma unroll
    for (int q = 0; q < 4; ++q) gq[q] = *(const f32x4*)(ng + c0 + 4 * q);
    for (int row0 = blockIdx.x * 8 + wid; row0 < nrows; row0 += 3 * rstride) {
        u32x4 f[3][2], bk[3][2], o8[3][2];
#pragma unroll
        for (int k = 0; k < 3; ++k) {
            const int rk = row0 + k * rstride, row = rk < nrows ? rk : row0;
#pragma unroll
            for (int j = 0; j < 2; ++j) {
                f[k][j] = *(const u32x4*)(HF + (size_t)row * DM + c0 + 8 * j); bk[k][j] = *(const u32x4*)(HB + (size_t)row * DM + c0 + 8 * j);
                o8[k][j] = *(const u32x4*)(QKV + (size_t)row * 3328 + 2048 + c0 + 8 * j);
            }
        }
#pragma unroll
        for (int k = 0; k < 3; ++k) {
            const int row = row0 + k * rstride;
            if (row < nrows) {
                float v[16]; float ss = 0.f;
#pragma unroll
                for (int j = 0; j < 2; ++j)
#pragma unroll
                    for (int i = 0; i < 4; ++i) { v[8 * j + 2 * i] = bflo(f[k][j][i]) + bflo(bk[k][j][i]); v[8 * j + 2 * i + 1] = bfhi(f[k][j][i]) + bfhi(bk[k][j][i]); }
#pragma unroll
                for (int i = 0; i < 16; ++i) ss += v[i] * v[i];
                ss += __shfl_xor(ss, 1); ss += __shfl_xor(ss, 2); ss += __shfl_xor(ss, 4);
                const float rstd = rsqrtf(ss * (1.0f / 128.0f) + 1e-6f);
#pragma unroll
                for (int j = 0; j < 2; ++j) {
                    float y[8];
#pragma unroll
                    for (int i = 0; i < 4; ++i) {
                        const float oa = bflo(o8[k][j][i]), ob = bfhi(o8[k][j][i]);
                        const f32x4 gg = gq[2 * j + (i >> 1)];
                        const float ga = gg[2 * (i & 1)], gb = gg[2 * (i & 1) + 1];
                        y[2 * i] = v[8 * j + 2 * i] * rstd * ga / (1.f + __expf(-oa));
                        y[2 * i + 1] = v[8 * j + 2 * i + 1] * rstd * gb / (1.f + __expf(-ob));
                    }
                    u32x4 p; p[0] = pk2(y[0], y[1]); p[1] = pk2(y[2], y[3]); p[2] = pk2(y[4], y[5]); p[3] = pk2(y[6], y[7]);
                    *(u32x4*)(ATT + (size_t)row * DM + c0 + 8 * j) = p;
                }
            }
        }
    }
}

DI void phase_conv(const Args& a, int l, int half, int nrows) {
    const bf16_t* U = (const bf16_t*)(a.ws + WS_U);
    bf16_t* ACT = (bf16_t*)(a.ws + WS_ACT);
    const int kind = l % 3, bs = lbase(l);
    const float* cw = a.in[bs + off_wout(kind) + 3]; const float* cb = a.in[bs + off_wout(kind) + 4];
    const float* ssq = (const float*)(a.ws + WS_SSQ) + (size_t)(2 * l + 1) * MROWS;
    const float* sb_up = (const float*)(a.ws + WS_SB) + (size_t)l * SB_LAYER + 9 * SB_IN_LD + (half ? UP_T0 * 256 : 0);
    const int upitch = half ? (22 - UP_T0) * 256 : UP_T0 * 256, cpr = upitch >> 3, c0 = half ? UP_T0 * 128 : 0;
    const int nunits = (nrows >> 3) * cpr;
    for (int u = blockIdx.x * 512 + otid(); u < nunits; u += gridDim.x * 512) {
        const int strip = u / cpr, chunk = u - strip * cpr, r0 = strip * 8;
        const int fa = c0 + chunk * 4, uca = 256 * (chunk >> 5) + 4 * (chunk & 31);
        const int ub = r0 < MLAT ? (r0 >> 11) : 8;
        f32x4 wa[3], wg[3];
#pragma unroll
        for (int j = 0; j < 3; ++j) { wa[j] = *(const f32x4*)(cw + (size_t)j * 2 * FFN + fa); wg[j] = *(const f32x4*)(cw + (size_t)j * 2 * FFN + FFN + fa); }
        const f32x4 ba = *(const f32x4*)(cb + fa), bg = *(const f32x4*)(cb + FFN + fa);
        const f32x4 sa = *(const f32x4*)(sb_up + (size_t)ub * SB_UP_LD + uca), sg = *(const f32x4*)(sb_up + (size_t)ub * SB_UP_LD + uca + 128);
        const bool has_prev = r0 < MLAT ? (r0 & 2047) != 0 : ((r0 - MLAT) & 255) != 0;
        const int rn = r0 + 8;
        const bool has_next = rn < MLAT ? (rn & 2047) != 0 : (rn < MROWS && ((rn - MLAT) & 255) != 0);
        const bf16_t* up = U + (size_t)r0 * upitch + uca;
        u32x2 ua[10], ug[10]; float rsv[10];
#pragma unroll
        for (int i = 0; i < 10; ++i) {
            int ro = i - 1; if (i == 0 && !has_prev) ro = 0; if (i == 9 && !has_next) ro = 7;
            const bf16_t* rp = up + (ptrdiff_t)ro * upitch;
            ua[i] = *(const u32x2*)(rp); ug[i] = *(const u32x2*)(rp + 128); rsv[i] = ssq[r0 + ro];
        }
        f32x4 xa[10], xg[10];
#pragma unroll
        for (int i = 0; i < 10; ++i) {
            const float rs_ = rsqrtf(rsv[i] * (1.0f / 1024.0f) + 1e-6f);
            xa[i] = (f32x4){bflo(ua[i][0]), bfhi(ua[i][0]), bflo(ua[i][1]), bfhi(ua[i][1])} * rs_ + sa;
            xg[i] = (f32x4){bflo(ug[i][0]), bfhi(ug[i][0]), bflo(ug[i][1]), bfhi(ug[i][1])} * rs_ + sg;
        }
        const float fp = has_prev ? 1.f : 0.f, fn = has_next ? 1.f : 0.f;
        xa[0] = xa[0] * fp; xg[0] = xg[0] * fp; xa[9] = xa[9] * fn; xg[9] = xg[9] * fn;
#pragma unroll
        for (int i = 0; i < 8; ++i) {
            const f32x4 av = ba + wa[0] * xa[i] + wa[1] * xa[i + 1] + wa[2] * xa[i + 2];
            const f32x4 gv = bg + wg[0] * xg[i] + wg[1] * xg[i + 1] + wg[2] * xg[i + 2];
            float y[4];
#pragma unroll
            for (int q = 0; q < 4; ++q) y[q] = av[q] * gv[q] / (1.f + __expf(-gv[q]));
            u32x2 p; p[0] = pk2(y[0], y[1]); p[1] = pk2(y[2], y[3]);
            *(u32x2*)(ACT + (size_t)(r0 + i) * FFN + fa) = p;
        }
    }
}

DI void phase_conv_fix(const Args& a, int l, int nrows) {
    const float* EDGE = (const float*)(a.ws + WS_U);
    bf16_t* ACT = (bf16_t*)(a.ws + WS_ACT);
    const int kind = l % 3, bs = lbase(l);
    const float* cw = a.in[bs + off_wout(kind) + 3]; const float* cb = a.in[bs + off_wout(kind) + 4];
    const int nb = (nrows >> 6) - 1, total = nb * 704;
    for (int u = blockIdx.x * 512 + otid(); u < total; u += gridDim.x * 512) {
        const int bb = u / 704, ch = (u - bb * 704) * 4, r = 64 * (bb + 1);
        const bool interior = r < MLAT ? (r & 2047) != 0 : ((r - MLAT) & 255) != 0;
        if (!interior) continue;
        const float* eA = EDGE + ((size_t)(bb * 4 + 2) * 2) * FFN + ch;
        const float* eB = eA + 2 * FFN;
        const float* eC = EDGE + ((size_t)((bb + 1) * 4) * 2) * FFN + ch;
        const float* eD = eC + 2 * FFN;
        f32x4 wa[3], wg[3];
#pragma unroll
        for (int j = 0; j < 3; ++j) { wa[j] = *(const f32x4*)(cw + (size_t)j * 2 * FFN + ch); wg[j] = *(const f32x4*)(cw + (size_t)j * 2 * FFN + FFN + ch); }
        const f32x4 ba = *(const f32x4*)(cb + ch), bg = *(const f32x4*)(cb + FFN + ch);
        const f32x4 aA = *(const f32x4*)(eA), gA = *(const f32x4*)(eA + FFN), aB = *(const f32x4*)(eB), gB = *(const f32x4*)(eB + FFN);
        const f32x4 aC = *(const f32x4*)(eC), gC = *(const f32x4*)(eC + FFN), aD = *(const f32x4*)(eD), gD = *(const f32x4*)(eD + FFN);
        const f32x4 a1 = ba + wa[0] * aA + wa[1] * aB + wa[2] * aC, g1 = bg + wg[0] * gA + wg[1] * gB + wg[2] * gC;
        const f32x4 a2 = ba + wa[0] * aB + wa[1] * aC + wa[2] * aD, g2 = bg + wg[0] * gB + wg[1] * gC + wg[2] * gD;
        float y[4], z[4];
#pragma unroll
        for (int q = 0; q < 4; ++q) { y[q] = a1[q] * g1[q] / (1.f + __expf(-g1[q])); z[q] = a2[q] * g2[q] / (1.f + __expf(-g2[q])); }
        u32x2 p; p[0] = pk2(y[0], y[1]); p[1] = pk2(y[2], y[3]);
        *(u32x2*)(ACT + (size_t)(r - 1) * FFN + ch) = p;
        p[0] = pk2(z[0], z[1]); p[1] = pk2(z[2], z[3]);
        *(u32x2*)(ACT + (size_t)r * FFN + ch) = p;
    }
}

#define XB_TMO      128
#define XB_XCNT(j)  (256  + 64 * (j))
#define XB_XSUB(j)  (1280 + 64 * (j))
#define XB_XGEN(j)  (2304 + 64 * (j))
#define XB_TOP      3328
#define XB_TOPGEN   3392
#define XCD_BAR_WORDS 3456
#define XB_SPIN_CAP (1u << 18)

__device__ __forceinline__ unsigned xb_ld(unsigned* p)              { return __hip_atomic_load(p, __ATOMIC_RELAXED, __HIP_MEMORY_SCOPE_AGENT); }
__device__ __forceinline__ unsigned xb_add(unsigned* p, unsigned v) { return __hip_atomic_fetch_add(p, v, __ATOMIC_RELAXED, __HIP_MEMORY_SCOPE_AGENT); }
__device__ __forceinline__ unsigned xb_xcc_id() { return (unsigned)__builtin_amdgcn_s_getreg((3 << 11) | 20) & 0xFu; }
#define XB_SPIN(cond, bar) do { unsigned _sp = 0; while (cond) { __builtin_amdgcn_s_sleep(1); \
    if ((++_sp & 255u) == 0u) { if (xb_ld(&(bar)[XB_TMO])) break; if (_sp > XB_SPIN_CAP) { atomicAdd(&(bar)[XB_TMO], 1u); break; } } } } while (0)

struct XcdBarrier {
    unsigned* bar; unsigned x;
    volatile LAS unsigned* st;
};

__device__ __forceinline__ XcdBarrier xcd_barrier_post(unsigned* bar, volatile LAS unsigned* st) {
    XcdBarrier b; b.bar = bar; b.x = xb_xcc_id(); b.st = st;
    if (otid() == 0) (void)xb_add(&bar[XB_XCNT(b.x)], 1u);
    return b;
}
__device__ __forceinline__ void xcd_barrier_complete(unsigned* bar, unsigned x, unsigned& nloc, unsigned& nx) {
    const unsigned G = gridDim.x * gridDim.y * gridDim.z;
    unsigned sum, cnt, mine, sp = 0u;
    for (;;) {
        sum = 0u; cnt = 0u; mine = 0u;
#pragma unroll
        for (unsigned j = 0; j < 16; ++j) { const unsigned c = xb_ld(&bar[XB_XCNT(j)]); sum += c; cnt += (c > 0u) ? 1u : 0u; mine = (j == x) ? c : mine; }
        if (sum == G) break;
        __builtin_amdgcn_s_sleep(1);
        if ((++sp & 255u) == 0u) { if (xb_ld(&bar[XB_TMO])) break; if (sp > XB_SPIN_CAP) { atomicAdd(&bar[XB_TMO], 1u); break; } }
    }
    nloc = mine > 0u ? mine : 1u; nx = cnt > 0u ? cnt : 1u;
}

__device__ __forceinline__ void xcd_barrier(const XcdBarrier& b) {
    asm volatile("s_waitcnt vmcnt(0)" ::: "memory");
    __syncthreads();
    if (otid() == 0) {
        unsigned* bar = b.bar;
        __builtin_amdgcn_s_waitcnt(0);
        unsigned nloc = b.st[0], nx = b.st[1];
        if (nloc == 0u) { xcd_barrier_complete(bar, b.x, nloc, nx); b.st[0] = nloc; b.st[1] = nx; }
        const unsigned old = xb_add(&bar[XB_XSUB(b.x)], 1u);
        const unsigned gen = old / nloc;
        if (old + 1u == (gen + 1u) * nloc) {
            __builtin_amdgcn_fence(__ATOMIC_RELEASE, "agent");
            asm volatile("s_waitcnt vmcnt(0)" ::: "memory");
            const unsigned og = xb_add(&bar[XB_TOP], 1u);
            const unsigned tg = og / nx;
            if (og + 1u == (tg + 1u) * nx) xb_add(&bar[XB_TOPGEN], 1u);
            else XB_SPIN(xb_ld(&bar[XB_TOPGEN]) == tg, bar);
            __builtin_amdgcn_fence(__ATOMIC_ACQUIRE, "agent");
            xb_add(&bar[XB_XGEN(b.x)], 1u);
            asm volatile("s_waitcnt vmcnt(0)" ::: "memory");
        } else {
            XB_SPIN(xb_ld(&bar[XB_XGEN(b.x)]) == gen, bar);
            __builtin_amdgcn_fence(__ATOMIC_ACQUIRE, "agent");
            asm volatile("s_waitcnt vmcnt(0)" ::: "memory");
        }
    }
    __syncthreads();
}

__host__ __device__ inline bool phase_active(int ph) {
    if (ph == 0 || ph == 45) return true;
    const int l = (ph - 1) / 11, s = (ph - 1) % 11;
    if (s == 3) return (l % 3) == 1;
    if (s == 5 || s == 8 || s == 9) return false;
    if (s == 0) return l == 0;
    return true;
}

DI void run_phase(const Args& a, char* shm, int ph) {
    if (ph == 0) { phase_prologue(a, shm); return; }
    float* X = (float*)(a.ws + WS_X);
    if (ph == 45) { phase_final_norm(X, a.in[57], a.out); return; }
    const int l = (ph - 1) / 11, s = (ph - 1) % 11, kind = l % 3, bs = lbase(l);
    const bool need_ctx = l < 3;
    const int Mff = need_ctx ? MROWS : MLAT;
    const float* mod_l = (const float*)(a.ws + WS_MOD) + (size_t)l * 9 * 6144;
    const float* Xl = l == 0 ? a.in[0] : X; const float* Xc = l == 0 ? a.in[2] : X + (size_t)MLAT * DM;
    bf16_t* H = (bf16_t*)(a.ws + WS_H);
    unsigned char* wb = a.ws + WS_W;
    float* ssq1 = (float*)(a.ws + WS_SSQ) + (size_t)(2 * l) * MROWS; float* ssq2 = ssq1 + MROWS;
    const float* sb_in = (const float*)(a.ws + WS_SB) + (size_t)l * SB_LAYER; const float* sb_up = sb_in + 9 * SB_IN_LD;
    if (s == 1 || s == 4 || s == 6 || s == 8 || s == 10) {
        Epi E; E.mode = 0; E.O = nullptr; E.ldo = 0; E.ropelim = 0; E.ropec = (const float*)(a.ws + WS_ROPE); E.ropes = E.ropec + 1024;
        E.G = (float*)(a.ws + WS_G); E.gate_b = nullptr; E.X = X; E.res_lat = nullptr; E.res_ctx = nullptr; E.gate = nullptr;
        E.ssq_in = nullptr; E.sbias = nullptr; E.sb_ld = 0; E.Hout = nullptr; E.hgain = (const float*)(a.ws + WS_HG); E.ssq_out = nullptr;
        E.cw = nullptr; E.cb = nullptr; E.ACT = nullptr; E.EDGE = nullptr;
        const bf16_t* A = H; const bf16_t* Bt = (const bf16_t*)(wb + WOFF_IN); int M = MROWS, N = 1024, K = 1024;
        if (s == 1) {
            E.O = (bf16_t*)(a.ws + WS_QKV); E.ldo = ninpad_of(kind); N = ninpad_of(kind);
            E.ssq_in = ssq1; E.sbias = sb_in; E.sb_ld = SB_IN_LD;
            if (kind == 0) { E.ropelim = 2048; } else if (kind == 1) { E.mode = 1; E.gate_b = a.in[bs + 4]; } else { E.ropelim = 1280; }
        } else if (s == 4) {
            E.mode = 2; E.res_lat = Xl; E.res_ctx = Xc; E.gate = mod_l + 2048;
            E.Hout = H; E.hgain = (const float*)(a.ws + WS_HG) + (size_t)((4 + l) * 9) * 1024; E.ssq_out = ssq2;
            A = (const bf16_t*)(a.ws + WS_ATT); Bt = (const bf16_t*)(wb + WOFF_OUT); M = Mff;
        } else if (s == 10) {
            E.mode = 2; E.res_lat = X; E.res_ctx = X + (size_t)MLAT * DM; E.gate = mod_l + 5120;
            if (l < 3) { E.Hout = H; E.hgain = (const float*)(a.ws + WS_HG) + (size_t)((l + 1) * 9) * 1024; E.ssq_out = ssq1 + 2 * MROWS; }
            A = (const bf16_t*)(a.ws + WS_ACT); Bt = (const bf16_t*)(wb + WOFF_DOWN); M = Mff; K = FFN;
        } else {
            E.mode = 4; N = 2 * FFN; M = Mff;
            E.ssq_in = ssq2; E.sbias = sb_up; E.sb_ld = SB_UP_LD;
            E.cw = a.in[bs + off_wout(kind) + 3]; E.cb = a.in[bs + off_wout(kind) + 4]; E.ACT = (bf16_t*)(a.ws + WS_ACT); E.EDGE = (float*)(a.ws + WS_U);
            Bt = (const bf16_t*)(wb + WOFF_UP);
        }
        if (s == 1 && kind != 1) {
            float* rl = (float*)(shm + 131072 + 1024 + 10240);
            for (int i = otid(); i < 2048; i += 512) rl[i] = E.ropec[i];
            __syncthreads();
        }
        run_gemm(shm, A, Bt, M, N, K, E);
        {
            int cl = -1, which = 0;
            if (s == 1 && l >= 1) { cl = l; which = 8; }
            else if (s == 4 && l <= 2) { cl = l + 1; which = 1; }
            else if (s == 10 && l <= 2) { cl = l + 1; which = 6; }
            if (cl >= 0) {
                const int nwg = (M >> 8) * (N >> 8), G = (int)gridDim.x, rem = nwg % G, c = (int)blockIdx.x;
                if (rem == 0) phase_convert(a, shm, cl, which, c, G);
                else if (c >= rem) phase_convert(a, shm, cl, which, c - rem, G - rem);
            }
        }
        return;
    }
    switch (s) {
    case 0:
        phase_convert(a, shm, 0, 15, (int)blockIdx.x, (int)gridDim.x);
        {
            float* HG = (float*)(a.ws + WS_HG); const float* modb = (const float*)(a.ws + WS_MOD);
            for (int i = blockIdx.x * 512 + otid(); i < 2 * 4 * 9 * 1024; i += gridDim.x * 512) {
                const int c = i & 1023, rb = (i >> 10) % 9, tl = i / (9 * 1024), ll = tl & 3, t = tl >> 2, kk = ll % 3;
                const float g = t ? a.in[lbase(ll) + off_wout(kk) + 1][c] : a.in[lbase(ll) + 2][c];
                HG[i] = g * (1.0f + modb[(size_t)(ll * 9 + rb) * 6144 + (t ? 4096 : 1024) + c]);
            }
        }
        phase_prenorm(Xl, Xc, a.in[bs + 2], mod_l, 1024, H, ssq1, MROWS);
        break;
    case 2:
#ifndef NO_DA
        if (kind == 0) phase_da(a, shm, l, need_ctx);
#endif
#ifndef NO_ML
        if (kind == 1) phase_mlstm(a, shm);
#endif
#ifndef NO_SWA
        if (kind == 2) phase_swa(a, shm, l, need_ctx);
#endif
        break;
    case 3:
        phase_ml_finish(a, l, Mff);
        break;
    case 7:
        phase_conv_fix(a, l, Mff);
        break;
    }
}

__global__ void __launch_bounds__(512, 2) mega_fwd(Args a) {
    extern __shared__ __attribute__((aligned(16))) char shm[];
    volatile LAS unsigned* st = (volatile LAS unsigned*)((LAS char*)shm + 131072 + 256);
    if (otid() == 0) { st[0] = 0u; st[1] = 0u; }
    __syncthreads();
    XcdBarrier xb = xcd_barrier_post((unsigned*)(a.ws + WS_BAR), st);
    for (int ph = a.ph_lo; ph < a.ph_hi; ++ph) {
        if (!phase_active(ph)) continue;
        int reps = 1;
#ifdef PROBE_REP
        if (ph > 0 && ph < 45) {
            const int l_ = (ph - 1) / 11, s_ = (ph - 1) % 11, k_ = l_ % 3;
            bool rep = false;
            if (PROBE_REP == 1) rep = (s_ == 1);
            if (PROBE_REP == 2) rep = (s_ == 6);
            if (PROBE_REP == 3) rep = (s_ == 2 && k_ == 0);
            if (PROBE_REP == 4) rep = (s_ == 2 && k_ != 0) || s_ == 3;
            if (PROBE_REP == 5) rep = (s_ == 7);
            if (rep) reps = 2;
        }
#endif
        for (int r = 0; r < reps; ++r) {
            run_phase(a, shm, ph);
            if (a.use_sync && (ph + 1 < a.ph_hi || r + 1 < reps)) {
                if (a.use_sync == 2) cg::this_grid().sync();
                xcd_barrier(xb);
            }
        }
    }
}

extern "C" void kernel_launch(void* const* d_in, const int* in_sizes, int n_in, void* d_out, int out_size, void* d_ws, size_t ws_size, hipStream_t stream) {
    static int grid_blocks = 0;
    if (!grid_blocks) {
        int dev = 0, cus = 0, per_cu = 0;
        hipGetDevice(&dev);
        hipDeviceGetAttribute(&cus, hipDeviceAttributeMultiprocessorCount, dev);
        hipFuncSetAttribute((const void*)mega_fwd, hipFuncAttributeMaxDynamicSharedMemorySize, LDS_BYTES);
        hipOccupancyMaxActiveBlocksPerMultiprocessor(&per_cu, mega_fwd, 512, LDS_BYTES);
        if (per_cu < 1) { fprintf(stderr, "occupancy query returned %d\n", per_cu); per_cu = 1; }
        grid_blocks = cus * 1;
    }
    Args a{};
    for (int i = 0; i < 58; ++i) a.in[i] = (const float*)d_in[i];
    a.out = (float*)d_out; a.ws = (unsigned char*)d_ws; a.pad = 0;
#if MK_ONE_LAUNCH
    a.ph_lo = 0; a.ph_hi = NPHASE; a.use_sync = 1;
    hipMemsetAsync((char*)d_ws + WS_BAR, 0, ZERO_BYTES, stream);
    void* args[] = {&a};
    hipError_t e = hipLaunchCooperativeKernel((const void*)mega_fwd, dim3(grid_blocks), dim3(512), args, LDS_BYTES, stream);
    if (e != hipSuccess) fprintf(stderr, "cooperative launch failed: %s (grid %d)\n", hipGetErrorString(e), grid_blocks);
#else
    a.use_sync = 0;
    for (int ph = 0; ph < NPHASE; ++ph) {
        if (!phase_active(ph)) continue;
        a.ph_lo = ph; a.ph_hi = ph + 1;
        hipLaunchKernelGGL(mega_fwd, dim3(grid_blocks), dim3(512), LDS_BYTES, stream, a);
    }
#endif
}
```

```cpp
#include <hip/hip_runtime.h>
#include <hip/hip_cooperative_groups.h>
#include <cstdio>
#include <type_traits>
namespace cg = cooperative_groups;

#ifndef MK_ONE_LAUNCH
#define MK_ONE_LAUNCH 1
#endif

#define DI __device__ __forceinline__
typedef float f32x2 __attribute__((ext_vector_type(2)));
typedef float f32x16 __attribute__((ext_vector_type(16)));
typedef unsigned u32x2 __attribute__((ext_vector_type(2)));
typedef short s16x4 __attribute__((ext_vector_type(4)));
typedef __bf16 bf16x2_t __attribute__((ext_vector_type(2)));

namespace pg8 {
#define PG8_LAS __attribute__((address_space(3)))
typedef unsigned short bf16_t;
typedef short bf16x8 __attribute__((ext_vector_type(8)));
typedef float f32x4 __attribute__((ext_vector_type(4)));
typedef unsigned u32x4 __attribute__((ext_vector_type(4)));
constexpr int BM = 256, BK = 64, HALF = 128, HTB = HALF * BK * 2  , STAGE_BYTES = 8 * HTB, NXCD = 8, WGM = 8;

__host__ __device__ __forceinline__ int lds_byte(int r, int c) { const int st = (r >> 4) * 2 + (c >> 5), rr = r & 15, cc = c & 31, ob = rr * 64 + cc * 2; return st * 1024 + (ob ^ (((ob >> 9) & 1) << 5)); }
__host__ __device__ __forceinline__ void stage_rc(int b, int& R, int& C) { const int st = b / 1024, sb = b % 1024, swz = sb ^ (((sb >> 9) & 1) << 5); R = (st >> 1) * 16 + swz / 64; C = (st & 1) * 32 + (swz % 64) / 2; }
__host__ __device__ __forceinline__ int perm32(int rho) { const int n = rho >> 4, i = rho & 15; return 8 * (i >> 2) + 4 * n + (i & 3); }

struct Unit { int pm, pn; };
struct Gemm { const bf16_t* A; const bf16_t* Bt; int M, N, K; };

struct StaticOrder {
    int nM, nN, nwg, G, c;
    __host__ __device__ void init(int M, int N, int G_, int c_) { nM = M / BM; nN = N / BM; nwg = nM * nN; G = G_; c = c_; }
    __host__ __device__ bool next(int i, Unit& u) const {
        const long L = (long)i * G + c; if (L >= nwg) return false;
        int wgid = (int)L; { const int q = nwg / NXCD, r = nwg % NXCD, xcd = wgid % NXCD, off = wgid / NXCD; wgid = (xcd < r ? xcd * (q + 1) : r * (q + 1) + (xcd - r) * q) + off; }
        const int nig = WGM * nN, gid = wgid / nig, fm = gid * WGM, gsz = (nM - fm) < WGM ? (nM - fm) : WGM;
        u.pm = fm + ((wgid % nig) % gsz); u.pn = (wgid % nig) / gsz; return true;
    }
    __device__ __forceinline__ void a_ready(const Unit&) const {}
    __device__ __forceinline__ void done(const Unit&) const {}
};

template <class Epi, class Sched>
__device__ __forceinline__ void gemm_phase(PG8_LAS unsigned char* lds, const Gemm g, const Sched& S, const Epi& E) {
    int tid = threadIdx.x; asm volatile("" : "+v"(tid)); const int wid = __builtin_amdgcn_readfirstlane(tid >> 6), wr = wid >> 2, wc = wid & 3;
    const int K = g.K, nt = K / BK;
    const size_t kstep = (size_t)(BK * 2);
    const size_t hstep = (size_t)HALF * K * 2;
    const size_t tstep = 2 * hstep;
    const unsigned ldsw = (unsigned)wid * 1024u;
    unsigned voffA[2], voffB[2]; int aoff, boff;
#define PG8_DERIVE() do { int t_ = tid; asm volatile("" : "+v"(t_)); const int ln_ = t_ & 63, fr_ = ln_ & 15, fq_ = ln_ >> 4; \
        _Pragma("unroll") for (int i = 0; i < 2; ++i) { int R, C; stage_rc(t_ * 16 + i * 8192, R, C); const int Rb = Epi::PERM ? ((R & ~31) + perm32(R & 31)) : R; \
            voffA[i] = (unsigned)(R * K + C) * 2u; voffB[i] = (unsigned)(Rb * K + C) * 2u; } \
        aoff = lds_byte(wr * 64 + fr_, fq_ * 8); boff = lds_byte(wc * 32 + fr_, fq_ * 8); } while (0)
    PG8_DERIVE();
#define PG8_SA(b, h) (((b) * 2 + (h)) * HTB)
#define PG8_SB(b, h) ((4 + (b) * 2 + (h)) * HTB)
#define PG8_STAGE(bufoff, gbase, voff) do { _Pragma("unroll") for (int _i = 0; _i < 2; ++_i) \
        __builtin_amdgcn_global_load_lds((const unsigned*)((const char*)(gbase) + (voff)[_i]), (PG8_LAS unsigned*)(lds + (bufoff) + ldsw + _i * 8192), 16, 0, 0); } while (0)
#define PG8_LDA(dst, b, h) do { _Pragma("unroll") for (int m = 0; m < 4; ++m) _Pragma("unroll") for (int k = 0; k < 2; ++k) dst[m][k] = *(const PG8_LAS bf16x8*)(lds + PG8_SA(b, h) + aoff + m * 2048 + k * 1024); } while (0)
#define PG8_LDB(dst, b, h) do { _Pragma("unroll") for (int n = 0; n < 2; ++n) _Pragma("unroll") for (int k = 0; k < 2; ++k) dst[n][k] = *(const PG8_LAS bf16x8*)(lds + PG8_SB(b, h) + boff + n * 2048 + k * 1024); } while (0)
#define PG8_MMA(ai, bj, At, Bt) do { __builtin_amdgcn_s_setprio(1); _Pragma("unroll") for (int m = 0; m < 4; ++m) _Pragma("unroll") for (int n = 0; n < 2; ++n) _Pragma("unroll") for (int k = 0; k < 2; ++k) \
        acc[ai][bj][m][n] = __builtin_amdgcn_mfma_f32_16x16x32_bf16(Bt[n][k], At[m][k], acc[ai][bj][m][n], 0, 0, 0); __builtin_amdgcn_s_setprio(0); } while (0)
#define PG8_WAIT_V(n) asm volatile("s_waitcnt vmcnt(" #n ")" ::: "memory")
#define PG8_WAIT_L(n) asm volatile("s_waitcnt lgkmcnt(" #n ")" ::: "memory")
#define PG8_BAR __builtin_amdgcn_s_barrier()
#define PG8_SCHED __builtin_amdgcn_sched_barrier(0)
    Unit cur, nxt; int ui = 0;
    if (!S.next(0, cur)) return;
    f32x4 acc[2][2][4][2];
#pragma unroll
    for (int a = 0; a < 2; ++a)
#pragma unroll
        for (int b = 0; b < 2; ++b)
#pragma unroll
            for (int m = 0; m < 4; ++m)
#pragma unroll
                for (int n = 0; n < 2; ++n) acc[a][b][m][n] = (f32x4){0.f, 0.f, 0.f, 0.f};
    bf16x8 At[4][2], B0[2][2], B1[2][2];
    const char* cA = (const char*)g.A + (size_t)cur.pm * tstep; const char* cB = (const char*)g.Bt + (size_t)cur.pn * tstep;
    S.a_ready(cur);
    PG8_STAGE(PG8_SB(0, 0), cB, voffB); PG8_STAGE(PG8_SA(0, 0), cA, voffA); PG8_STAGE(PG8_SB(0, 1), cB + hstep, voffB); PG8_STAGE(PG8_SA(0, 1), cA + hstep, voffA);
    if (wr == 1) PG8_BAR;
    PG8_WAIT_V(4); PG8_BAR;
    PG8_STAGE(PG8_SB(1, 0), cB + kstep, voffB); PG8_STAGE(PG8_SA(1, 0), cA + kstep, voffA); PG8_STAGE(PG8_SB(1, 1), cB + hstep + kstep, voffB);
    PG8_WAIT_V(6); PG8_BAR;
    for (;;) {
        const bool has_next = S.next(ui + 1, nxt);
        const char* nA = has_next ? (const char*)g.A + (size_t)nxt.pm * tstep : cA; const char* nB = has_next ? (const char*)g.Bt + (size_t)nxt.pn * tstep : cB;
        for (int t = 0; t < nt; t += 2) {
            const bool last = (t == nt - 2);
            const char* a1 = cA + (size_t)(t + 1) * kstep;
            const char* a2 = last ? nA : cA + (size_t)(t + 2) * kstep; const char* b2 = last ? nB : cB + (size_t)(t + 2) * kstep;
            const char* a3 = a2 + kstep; const char* b3 = b2 + kstep;
            if (last && has_next) S.a_ready(nxt);
            PG8_LDB(B0, 0, 0); PG8_SCHED; PG8_LDA(At, 0, 0); PG8_STAGE(PG8_SA(1, 1), a1 + hstep, voffA);
            PG8_WAIT_L(8); PG8_BAR; PG8_WAIT_L(0); PG8_MMA(0, 0, At, B0); PG8_BAR; PG8_SCHED;
            PG8_LDB(B1, 0, 1); PG8_STAGE(PG8_SB(0, 0), b2, voffB);
            PG8_BAR; PG8_WAIT_L(0); PG8_MMA(0, 1, At, B1); PG8_BAR;
            PG8_LDA(At, 0, 1); PG8_STAGE(PG8_SA(0, 0), a2, voffA);
            PG8_BAR; PG8_WAIT_L(0); PG8_MMA(1, 0, At, B0); PG8_BAR; PG8_SCHED;
            PG8_STAGE(PG8_SB(0, 1), b2 + hstep, voffB);
            PG8_WAIT_V(6); PG8_BAR; PG8_MMA(1, 1, At, B1); PG8_BAR;
            PG8_LDB(B0, 1, 0); PG8_SCHED; PG8_LDA(At, 1, 0); PG8_STAGE(PG8_SA(0, 1), a2 + hstep, voffA);
            PG8_WAIT_L(8); PG8_BAR; PG8_WAIT_L(0); PG8_MMA(0, 0, At, B0); PG8_BAR; PG8_SCHED;
            PG8_LDB(B1, 1, 1); PG8_STAGE(PG8_SB(1, 0), b3, voffB);
            PG8_BAR; PG8_WAIT_L(0); PG8_MMA(0, 1, At, B1); PG8_BAR;
            PG8_LDA(At, 1, 1); PG8_STAGE(PG8_SA(1, 0), a3, voffA);
            PG8_BAR; PG8_WAIT_L(0); PG8_MMA(1, 0, At, B0); PG8_BAR; PG8_SCHED;
            PG8_STAGE(PG8_SB(1, 1), b3 + hstep, voffB);
            PG8_WAIT_V(6); PG8_BAR; PG8_MMA(1, 1, At, B1); PG8_BAR;
        }
        if constexpr (!Epi::AFTER_DRAIN) { { int t_ = tid; asm volatile("" : "+v"(t_)); const int ln_ = t_ & 63; E(acc, cur, wr, wc, ln_ & 15, ln_ >> 4); } S.done(cur); PG8_DERIVE(); }
        if (!has_next) break;
#pragma unroll
        for (int a = 0; a < 2; ++a)
#pragma unroll
            for (int b = 0; b < 2; ++b)
#pragma unroll
                for (int m = 0; m < 4; ++m)
#pragma unroll
                    for (int n = 0; n < 2; ++n) acc[a][b][m][n] = (f32x4){0.f, 0.f, 0.f, 0.f};
        cur = nxt; cA = nA; cB = nB; ++ui;
    }
    PG8_WAIT_V(0);
    if (wr == 0) PG8_BAR;
    PG8_BAR;
    if constexpr (Epi::AFTER_DRAIN) { const int lane = tid & 63; E.fused(acc, cur, wr, wc, lane & 15, lane >> 4, lds, wid, lane); S.done(cur); }
#undef PG8_SA
#undef PG8_DERIVE
#undef PG8_SB
#undef PG8_STAGE
#undef PG8_LDA
#undef PG8_LDB
#undef PG8_MMA
#undef PG8_WAIT_V
#undef PG8_WAIT_L
#undef PG8_BAR
#undef PG8_SCHED
}
}

using pg8::bf16_t; using pg8::bf16x8; using pg8::f32x4; using pg8::u32x4;
#define LAS __attribute__((address_space(3)))
DI int otid() { int t = threadIdx.x; asm volatile("" : "+v"(t)); return t; }

constexpr int MROWS = 18432, MLAT = 16384, DM = 1024, FFN = 2816, FH = 1408;
constexpr size_t MiB = 1u << 20;
constexpr size_t WS_X = 0, WS_W = 72 * MiB, WS_H = 97 * MiB, WS_QKV = 133 * MiB, WS_U = 133 * MiB, WS_ACT = 241 * MiB,
                 WS_ATT = 250 * MiB, WS_HF = 286 * MiB, WS_HB = WS_H, WS_G = 322 * MiB, WS_MOD = 340 * MiB, WS_ROPE = 341 * MiB, WS_BAR = 342 * MiB, WS_SSQ = 343 * MiB, WS_SB = 344 * MiB, WS_HG = 349 * MiB;
constexpr int UP_T0 = 12;
constexpr int SB_IN_LD = 3328, SB_UP_LD = 5632;
constexpr size_t SB_LAYER = (size_t)9 * (SB_IN_LD + SB_UP_LD);
constexpr size_t ZERO_BYTES = 4 * MiB;
constexpr size_t WOFF_IN = 0, WOFF_OUT = 13 * MiB / 2, WOFF_UP = 17 * MiB / 2, WOFF_DOWN = 39 * MiB / 2;
constexpr int LDS_BYTES = 151552;
constexpr int NPHASE = 46;

struct Args { const float* in[58]; float* out; unsigned char* ws; int ph_lo, ph_hi, use_sync, pad; };

DI int lbase(int l) { return l == 0 ? 4 : l == 1 ? 19 : l == 2 ? 31 : 42; }
DI int off_wout(int k) { return k == 0 ? 9 : k == 1 ? 6 : 5; }
DI int nin_of(int k) { return k == 0 ? 3072 : k == 1 ? 3104 : 1536; }
DI int ninpad_of(int k) { return k == 0 ? 3072 : k == 1 ? 3328 : 1536; }

DI unsigned pk2(float lo, float hi) { f32x2 v = {lo, hi}; bf16x2_t b = __builtin_convertvector(v, bf16x2_t); return __builtin_bit_cast(unsigned, b); }
DI float bflo(unsigned u) { return __uint_as_float(u << 16); }
DI float bfhi(unsigned u) { return __uint_as_float(u & 0xffff0000u); }
DI f32x16 mfma32(bf16x8 a, bf16x8 b, f32x16 c) { return __builtin_amdgcn_mfma_f32_32x32x16_bf16(a, b, c, 0, 0, 0); }
DI int crow(int i, int h) { return (i & 3) + 8 * (i >> 2) + 4 * h; }
DI float fexp2(float x) { return __builtin_amdgcn_exp2f(x); }
DI float wave_sum(float v) {
#pragma unroll
    for (int d = 32; d >= 1; d >>= 1) v += __shfl_xor(v, d);
    return v;
}
DI f32x16 zero16() { f32x16 z;
#pragma unroll
    for (int i = 0; i < 16; ++i) z[i] = 0.f; return z; }
DI bf16x8 pack8(const f32x16& x, int s) {
    u32x4 p; p[0] = pk2(x[8 * s], x[8 * s + 1]); p[1] = pk2(x[8 * s + 2], x[8 * s + 3]); p[2] = pk2(x[8 * s + 4], x[8 * s + 5]); p[3] = pk2(x[8 * s + 6], x[8 * s + 7]);
    return __builtin_bit_cast(bf16x8, p);
}

struct Epi {
    static constexpr bool PERM = false, AFTER_DRAIN = false;
    int mode;
    bf16_t* O; int ldo; int ropelim;
    const float* ropec; const float* ropes;
    float* G; const float* gate_b;
    float* X; const float* res_lat; const float* res_ctx; const float* gate;
    const float* ssq_in; const float* sbias;
    int sb_ld;
    bf16_t* Hout; const float* hgain; float* ssq_out;
    const float* cw; const float* cb; bf16_t* ACT; float* EDGE;
    __device__ __forceinline__ void operator()(const f32x4 (&acc)[2][2][4][2], const pg8::Unit& u, int wr, int wc, int fr, int fq) const {
        const int row0 = u.pm * 256 + wr * 64 + fr, col0 = u.pn * 256 + wc * 32 + 4 * fq;
#ifdef EPI_ONLY
        if (EPI_ONLY == 2) {
#else
        if (mode == 2) {
#endif
            const int ub = u.pm < 64 ? (u.pm >> 3) : 8;
            const float* gp = gate + (size_t)ub * 6144;
            f32x4 gv[2][2], hg[2][2];
#pragma unroll
            for (int bj = 0; bj < 2; ++bj)
#pragma unroll
                for (int n = 0; n < 2; ++n) {
                    const int c = col0 + bj * 128 + n * 16;
                    gv[bj][n] = *(const f32x4*)(gp + c);
                    hg[bj][n] = *(const f32x4*)(hgain + (size_t)ub * 1024 + c);
                }
#pragma unroll
            for (int ai = 0; ai < 2; ++ai)
#pragma unroll
                for (int mp = 0; mp < 2; ++mp) {
                    f32x4 rv[2][2][2];
#pragma unroll
                    for (int mm = 0; mm < 2; ++mm) {
                        const int r = row0 + ai * 128 + (2 * mp + mm) * 16;
                        const float* rp = r < MLAT ? res_lat + (size_t)r * DM : res_ctx + (size_t)(r - MLAT) * DM;
#pragma unroll
                        for (int bj = 0; bj < 2; ++bj)
#pragma unroll
                            for (int n = 0; n < 2; ++n) rv[mm][bj][n] = *(const f32x4*)(rp + col0 + bj * 128 + n * 16);
                    }
#pragma unroll
                    for (int mm = 0; mm < 2; ++mm) {
                        const int m = 2 * mp + mm, r = row0 + ai * 128 + m * 16;
                        float* xp = X + (size_t)r * DM;
                        float ss = 0.f;
#pragma unroll
                        for (int bj = 0; bj < 2; ++bj)
#pragma unroll
                            for (int n = 0; n < 2; ++n) {
                                const int c = col0 + bj * 128 + n * 16;
                                const f32x4 xn = rv[mm][bj][n] + gv[bj][n] * acc[ai][bj][m][n];
                                *(f32x4*)(xp + c) = xn;
                                if (Hout) {
                                    ss += xn[0] * xn[0] + xn[1] * xn[1] + xn[2] * xn[2] + xn[3] * xn[3];
                                    const f32x4 hv = xn * hg[bj][n];
                                    u32x2 p; p[0] = pk2(hv[0], hv[1]); p[1] = pk2(hv[2], hv[3]);
                                    *(u32x2*)(Hout + (size_t)r * DM + c) = p;
                                }
                            }
                        if (Hout) {
                            ss += __shfl_xor(ss, 16); ss += __shfl_xor(ss, 32);
                            if (fq == 0) atomicAdd(ssq_out + r, ss);
                        }
                    }
                }
#ifdef EPI_ONLY
        } else if (EPI_ONLY == 1) {
#else
        } else if (mode == 1) {
#endif
            const float sc = u.pn < 2 ? 0.125f : 1.0f;
            const f32x4 gbv[2] = {*(const f32x4*)(gate_b + 4 * fq), *(const f32x4*)(gate_b + 16 + 4 * fq)};
            const int ub = u.pm < 64 ? (u.pm >> 3) : 8;
            f32x4 sbv[2][2];
#pragma unroll
            for (int bj = 0; bj < 2; ++bj)
#pragma unroll
                for (int n = 0; n < 2; ++n) sbv[bj][n] = *(const f32x4*)(sbias + (size_t)ub * sb_ld + col0 + bj * 128 + n * 16);
            float rsv[2][4];
#pragma unroll
            for (int ai = 0; ai < 2; ++ai)
#pragma unroll
                for (int m = 0; m < 4; ++m) rsv[ai][m] = rsqrtf(ssq_in[row0 + ai * 128 + m * 16] * (1.0f / 1024.0f) + 1e-6f);
#pragma unroll
            for (int ai = 0; ai < 2; ++ai)
#pragma unroll
                for (int m = 0; m < 4; ++m) {
                    const int r = row0 + ai * 128 + m * 16;
                    const float rs = rsv[ai][m];
                    if (u.pn == 12) {
                        if (wc == 0) {
#pragma unroll
                            for (int n = 0; n < 2; ++n) {
                                const int lc = n * 16 + 4 * fq;
                                *(f32x4*)(G + (size_t)r * 32 + lc) = acc[ai][0][m][n] * rs + sbv[0][n] + gbv[n];
                            }
                        }
                    } else {
                        bf16_t* op = O + (size_t)r * ldo;
#pragma unroll
                        for (int bj = 0; bj < 2; ++bj)
#pragma unroll
                            for (int n = 0; n < 2; ++n) {
                                const f32x4 v = (acc[ai][bj][m][n] * rs + sbv[bj][n]) * sc;
                                u32x2 p; p[0] = pk2(v[0], v[1]); p[1] = pk2(v[2], v[3]);
                                *(u32x2*)(op + col0 + bj * 128 + n * 16) = p;
                            }
                    }
                }
        } else if (mode == 4) {
            const int ub = u.pm < 64 ? (u.pm >> 3) : 8;
            const int ch0 = u.pn * 128 + wc * 32 + 4 * fq;
            const __amdgpu_buffer_rsrc_t ersrc = __builtin_amdgcn_make_buffer_rsrc((void*)EDGE, 0, 288 * 4 * 2 * FFN * 4, 0x00020000);
            LAS float* cst = (LAS float*)(unsigned)(131072 + 1024 + (wr * 4 + wc) * 1280);
            {
                const int ln = fr + 16 * fq, hv = ln >> 5, c = ln & 31;
                const float* cwp = cw + u.pn * 128 + wc * 32; const float* cbp = cb + u.pn * 128 + wc * 32; const float* sbp = sbias + (size_t)ub * sb_ld + u.pn * 256 + wc * 32;
                const float v01 = cwp[hv * 2 * FFN + c];
                const float v23 = cwp[(hv ? FFN : 2 * 2 * FFN) + c];
                const float v45 = cwp[(hv ? 2 * 2 * FFN + FFN : 2 * FFN + FFN) + c];
                const float v67 = cbp[hv * FFN + c];
                const float v89 = sbp[hv * 128 + c];
                cst[ln] = v01; cst[64 + ln] = v23; cst[128 + ln] = v45; cst[192 + ln] = v67; cst[256 + ln] = v89;
            }
            float rsa[2][4];
#pragma unroll
            for (int ai = 0; ai < 2; ++ai)
#pragma unroll
                for (int m = 0; m < 4; ++m) rsa[ai][m] = rsqrtf(ssq_in[row0 + ai * 128 + m * 16] * (1.0f / 1024.0f) + 1e-6f);
#pragma unroll
            for (int n = 0; n < 2; ++n)
#pragma unroll
                for (int jp = 0; jp < 2; ++jp) {
                    __builtin_amdgcn_sched_barrier(0);
                    const int ch = ch0 + 16 * n + 2 * jp;
                    const int lc = 16 * n + 4 * fq + 2 * jp;
                    f32x2 wa[3], wg[3];
#pragma unroll
                    for (int j = 0; j < 3; ++j) { wa[j] = *(const LAS f32x2*)(cst + j * 32 + lc); wg[j] = *(const LAS f32x2*)(cst + (3 + j) * 32 + lc); }
                    const f32x2 ba = *(const LAS f32x2*)(cst + 6 * 32 + lc), bg = *(const LAS f32x2*)(cst + 7 * 32 + lc);
                    const f32x2 sa = *(const LAS f32x2*)(cst + 8 * 32 + lc), sg = *(const LAS f32x2*)(cst + 9 * 32 + lc);
#pragma unroll
                    for (int ai = 0; ai < 2; ++ai) {
                        const int seg = (row0 + ai * 128) >> 6;
                        const unsigned eo0 = fr < 2 ? (unsigned)(((seg * 4 + fr) * 2 * FFN + ch) * 4) : 0xf0000000u, eo3 = fr >= 14 ? (unsigned)(((seg * 4 + fr - 12) * 2 * FFN + ch) * 4) : 0xf0000000u;
                        float y[4][2], e0[4];
#pragma unroll
                        for (int jj = 0; jj < 2; ++jj) {
                            const int j = 2 * jp + jj;
                            float xa[4], xg[4];
#pragma unroll
                            for (int m = 0; m < 4; ++m) { xa[m] = acc[ai][0][m][n][j] * rsa[ai][m] + sa[jj]; xg[m] = acc[ai][1][m][n][j] * rsa[ai][m] + sg[jj]; }
#pragma unroll
                            for (int m = 0; m < 4; ++m) {
                                const int oa = m > 0 ? __builtin_amdgcn_mov_dpp(__builtin_bit_cast(int, xa[m > 0 ? m - 1 : 0]), 0x121, 0xf, 0xf, false) : 0;
                                const int og = m > 0 ? __builtin_amdgcn_mov_dpp(__builtin_bit_cast(int, xg[m > 0 ? m - 1 : 0]), 0x121, 0xf, 0xf, false) : 0;
                                const float pa = __builtin_bit_cast(float, __builtin_amdgcn_update_dpp(oa, __builtin_bit_cast(int, xa[m]), 0x111, 0xf, 0xf, false));
                                const float pg = __builtin_bit_cast(float, __builtin_amdgcn_update_dpp(og, __builtin_bit_cast(int, xg[m]), 0x111, 0xf, 0xf, false));
                                const int qa = m < 3 ? __builtin_amdgcn_mov_dpp(__builtin_bit_cast(int, xa[m < 3 ? m + 1 : 3]), 0x12f, 0xf, 0xf, false) : 0;
                                const int qg = m < 3 ? __builtin_amdgcn_mov_dpp(__builtin_bit_cast(int, xg[m < 3 ? m + 1 : 3]), 0x12f, 0xf, 0xf, false) : 0;
                                const float na = __builtin_bit_cast(float, __builtin_amdgcn_update_dpp(qa, __builtin_bit_cast(int, xa[m]), 0x101, 0xf, 0xf, false));
                                const float ng = __builtin_bit_cast(float, __builtin_amdgcn_update_dpp(qg, __builtin_bit_cast(int, xg[m]), 0x101, 0xf, 0xf, false));
                                const float av = ba[jj] + wa[0][jj] * pa + wa[1][jj] * xa[m] + wa[2][jj] * na;
                                const float gv = bg[jj] + wg[0][jj] * pg + wg[1][jj] * xg[m] + wg[2][jj] * ng;
                                y[m][jj] = av * gv * __builtin_amdgcn_rcpf(1.f + __expf(-gv));
                            }
                            if (jj == 0) { e0[0] = xa[0]; e0[1] = xg[0]; e0[2] = xa[3]; e0[3] = xg[3]; }
                            else {
                                u32x2 v;
                                v[0] = __builtin_bit_cast(unsigned, e0[0]); v[1] = __builtin_bit_cast(unsigned, xa[0]); __builtin_amdgcn_raw_buffer_store_b64(v, ersrc, (int)eo0, 0, 0);
                                v[0] = __builtin_bit_cast(unsigned, e0[1]); v[1] = __builtin_bit_cast(unsigned, xg[0]); __builtin_amdgcn_raw_buffer_store_b64(v, ersrc, (int)(eo0 + FFN * 4), 0, 0);
                                v[0] = __builtin_bit_cast(unsigned, e0[2]); v[1] = __builtin_bit_cast(unsigned, xa[3]); __builtin_amdgcn_raw_buffer_store_b64(v, ersrc, (int)eo3, 0, 0);
                                v[0] = __builtin_bit_cast(unsigned, e0[3]); v[1] = __builtin_bit_cast(unsigned, xg[3]); __builtin_amdgcn_raw_buffer_store_b64(v, ersrc, (int)(eo3 + FFN * 4), 0, 0);
                            }
                        }
#pragma unroll
                        for (int m = 0; m < 4; ++m) {
                            const int r = row0 + ai * 128 + m * 16;
                            *(unsigned*)(ACT + (size_t)r * FFN + ch) = pk2(y[m][0], y[m][1]);
                        }
                    }
                }
        } else if (mode == 3) {
#pragma unroll
            for (int ai = 0; ai < 2; ++ai)
#pragma unroll
                for (int m = 0; m < 4; ++m) {
                    bf16_t* op = O + (size_t)(row0 + ai * 128 + m * 16) * ldo;
#pragma unroll
                    for (int bj = 0; bj < 2; ++bj)
#pragma unroll
                        for (int n = 0; n < 2; ++n) {
                            const f32x4 v = acc[ai][bj][m][n];
                            u32x2 p; p[0] = pk2(v[0], v[1]); p[1] = pk2(v[2], v[3]);
                            *(u32x2*)(op + col0 + bj * 128 + n * 16) = p;
                        }
                }
        } else {
            const bool tile_rope = (u.pn * 256) < ropelim;
            const LAS float* ropeL = (const LAS float*)(unsigned)(131072 + 1024 + 10240);
            const int ub = u.pm < 64 ? (u.pm >> 3) : 8;
            f32x4 sbv[2][2];
#pragma unroll
            for (int bj = 0; bj < 2; ++bj)
#pragma unroll
                for (int n = 0; n < 2; ++n) sbv[bj][n] = *(const f32x4*)(sbias + (size_t)ub * sb_ld + col0 + bj * 128 + n * 16);
            float rsv[2][4];
#pragma unroll
            for (int ai = 0; ai < 2; ++ai)
#pragma unroll
                for (int m = 0; m < 4; ++m) rsv[ai][m] = rsqrtf(ssq_in[row0 + ai * 128 + m * 16] * (1.0f / 1024.0f) + 1e-6f);
#pragma unroll
            for (int ai = 0; ai < 2; ++ai)
#pragma unroll
                for (int m = 0; m < 4; ++m) {
                    const int r = row0 + ai * 128 + m * 16;
                    const float rs = rsv[ai][m];
                    bf16_t* op = O + (size_t)r * ldo;
                    if (tile_rope && r < MLAT) {
                        const int s = r & 2047, pos = (wc & 1) ? (s & 63) : (s >> 6);
                        const f32x4 cs = *(const LAS f32x4*)(ropeL + pos * 16 + 4 * fq), sn = *(const LAS f32x4*)(ropeL + 1024 + pos * 16 + 4 * fq);
#pragma unroll
                        for (int bj = 0; bj < 2; ++bj) {
                            const f32x4 x1 = acc[ai][bj][m][0] * rs + sbv[bj][0], x2 = acc[ai][bj][m][1] * rs + sbv[bj][1];
                            const f32x4 y1 = x1 * cs - x2 * sn, y2 = x2 * cs + x1 * sn;
                            u32x2 p; p[0] = pk2(y1[0], y1[1]); p[1] = pk2(y1[2], y1[3]);
                            *(u32x2*)(op + col0 + bj * 128) = p;
                            p[0] = pk2(y2[0], y2[1]); p[1] = pk2(y2[2], y2[3]);
                            *(u32x2*)(op + col0 + bj * 128 + 16) = p;
                        }
                    } else {
#pragma unroll
                        for (int bj = 0; bj < 2; ++bj)
#pragma unroll
                            for (int n = 0; n < 2; ++n) {
                                const f32x4 v = acc[ai][bj][m][n] * rs + sbv[bj][n];
                                u32x2 p; p[0] = pk2(v[0], v[1]); p[1] = pk2(v[2], v[3]);
                                *(u32x2*)(op + col0 + bj * 128 + n * 16) = p;
                            }
                    }
                }
        }
    }
};

DI void run_gemm(char* shm, const bf16_t* A, const bf16_t* Bt, int M, int N, int K, const Epi& E) {
    pg8::Gemm g; g.A = A; g.Bt = Bt; g.M = M; g.N = N; g.K = K;
    pg8::StaticOrder S; S.init(M, N, (int)gridDim.x, (int)blockIdx.x);
#ifndef NO_GEMM
    pg8::gemm_phase<Epi, pg8::StaticOrder>((LAS unsigned char*)shm, g, S, E);
#endif
    __syncthreads();
}

DI void phase_prologue(const Args& a, char* shm) {
    float* sc = (float*)shm;
    float* red = sc + 9 * 1024;
    const int tid = otid();
    for (int i = tid; i < 9 * 1024; i += 512) { const int r = i >> 10, k = i & 1023; const float v = r < 8 ? a.in[1][r * 1024 + k] : a.in[3][k]; sc[i] = v / (1.f + __expf(-v)); }
    __syncthreads();
    float* mod = (float*)(a.ws + WS_MOD);
    for (int item = blockIdx.x; item < 193; item += gridDim.x) {
        if (item < 192) {
            const int l = item / 48, j0 = (item % 48) * 128, col = tid & 127, kq = tid >> 7;
            const float* W = a.in[lbase(l)] + j0 + col;
            float acc[9];
#pragma unroll
            for (int r = 0; r < 9; ++r) acc[r] = 0.f;
            for (int k = kq * 256; k < kq * 256 + 256; k += 32) {
                float w[32];
#pragma unroll
                for (int j = 0; j < 32; ++j) w[j] = __builtin_nontemporal_load(W + (size_t)(k + j) * 6144);
#pragma unroll
                for (int j = 0; j < 32; j += 4)
#pragma unroll
                    for (int r = 0; r < 9; ++r) { const f32x4 s = *(const f32x4*)(sc + r * 1024 + k + j); acc[r] += s[0] * w[j] + s[1] * w[j + 1] + s[2] * w[j + 2] + s[3] * w[j + 3]; }
            }
#pragma unroll
            for (int r = 0; r < 9; ++r) red[(kq * 9 + r) * 128 + col] = acc[r];
            __syncthreads();
            for (int i = tid; i < 9 * 128; i += 512) {
                const int r = i >> 7, cc = i & 127;
                const float s = red[r * 128 + cc] + red[(9 + r) * 128 + cc] + red[(18 + r) * 128 + cc] + red[(27 + r) * 128 + cc];
                mod[(size_t)(l * 9 + r) * 6144 + j0 + cc] = s + a.in[lbase(l) + 1][j0 + cc];
            }
            __syncthreads();
        } else {
            float* ropec = (float*)(a.ws + WS_ROPE); float* ropes = ropec + 1024; float* lam = ropec + 2048;
            for (int i = tid; i < 1024; i += 512) {
                const int pos = i >> 4, f = i & 15;
                const float inv = powf(10000.0f, -(float)f / 16.0f), ang = (float)pos * inv;
                ropec[i] = cosf(ang); ropes[i] = sinf(ang);
            }
            if (tid < 2) {
                const int l = tid == 0 ? 0 : 3, bs = lbase(l);
                float s1 = 0.f, s2 = 0.f;
                for (int k = 0; k < 64; ++k) { s1 += a.in[bs + 4][k] * a.in[bs + 5][k]; s2 += a.in[bs + 6][k] * a.in[bs + 7][k]; }
                const float lam_init = 0.8f - 0.6f * expf(-0.3f * (float)l);
                lam[tid * 2] = expf(s1) - expf(s2) + lam_init; lam[tid * 2 + 1] = lam_init;
            }
        }
    }
}

DI void convert_st(const float* W, int K, int N, bf16_t* Wt, int kt, int nt4, int upperm, float* T, float* sh, const float* shift, float* sb, int sb_ld) {
    const int tid = otid(), k0 = kt * 64, n0 = nt4 * 256;
    __syncthreads();
#pragma unroll
    for (int it = 0; it < 8; ++it) {
        const int k = it * 8 + (tid >> 6), n4 = (tid & 63) * 4;
        f32x4 v = {0.f, 0.f, 0.f, 0.f};
        if (n0 + n4 < N) v = *(const f32x4*)(W + (size_t)(k0 + k) * N + n0 + n4);
        *(f32x4*)(T + k * 260 + n4) = v;
    }
    if (sb) { for (int i = tid; i < 576; i += 512) sh[i] = shift[(size_t)(i >> 6) * 6144 + k0 + (i & 63)]; }
    __syncthreads();
    const int n = tid >> 1, kh = tid & 1, nn = n0 + n;
    int row = nn;
    if (upperm) { const int f = nn < FFN ? nn : nn - FFN; row = 256 * (f >> 7) + (nn < FFN ? 0 : 128) + (f & 127); }
    float v[32];
#pragma unroll
    for (int i = 0; i < 32; ++i) v[i] = T[(32 * kh + i) * 260 + n];
    bf16_t* dst = Wt + (size_t)row * K + k0 + 32 * kh;
#pragma unroll
    for (int j = 0; j < 4; ++j) {
        u32x4 p; p[0] = pk2(v[8 * j], v[8 * j + 1]); p[1] = pk2(v[8 * j + 2], v[8 * j + 3]); p[2] = pk2(v[8 * j + 4], v[8 * j + 5]); p[3] = pk2(v[8 * j + 6], v[8 * j + 7]);
        *(u32x4*)(dst + 8 * j) = p;
    }
    if (sb) {
#pragma unroll
        for (int rb = 0; rb < 9; ++rb) {
            float p = 0.f;
#pragma unroll
            for (int i = 0; i < 32; i += 4) { const f32x4 s4 = *(const f32x4*)(sh + rb * 64 + 32 * kh + i); p += s4[0] * v[i] + s4[1] * v[i + 1] + s4[2] * v[i + 2] + s4[3] * v[i + 3]; }
            p += __shfl_xor(p, 1);
            if (kh == 0 && nn < N) atomicAdd(sb + (size_t)rb * sb_ld + row, p);
        }
    }
}
DI void phase_convert(const Args& a, char* shm, int l, int which, int idx, int nstride) {
    const int kind = l % 3, bs = lbase(l), nin = nin_of(kind), nint = (nin + 255) >> 8;
    const int n_in = (which & 1) ? nint * 16 : 0, n_out = (which & 2) ? 64 : 0, n_up = (which & 4) ? 22 * 16 : 0, n_down = (which & 8) ? 4 * 44 : 0;
    const int total = n_in + n_out + n_up + n_down;
    unsigned char* wb = a.ws + WS_W;
    float* T = (float*)shm; float* sh = T + 64 * 260;
    const float* mod_l = (const float*)(a.ws + WS_MOD) + (size_t)l * 9 * 6144;
    float* sb_in = (float*)(a.ws + WS_SB) + (size_t)l * SB_LAYER; float* sb_up = sb_in + 9 * SB_IN_LD;
    for (int item = idx; item < total; item += nstride) {
        int it = item;
        if (it < n_in) { convert_st(a.in[bs + 3], 1024, nin, (bf16_t*)(wb + WOFF_IN), it & 15, it >> 4, 0, T, sh, mod_l, sb_in, SB_IN_LD); continue; }
        it -= n_in;
        if (it < n_out) { convert_st(a.in[bs + off_wout(kind)], 1024, 1024, (bf16_t*)(wb + WOFF_OUT), it & 15, it >> 4, 0, T, sh, nullptr, nullptr, 0); continue; }
        it -= n_out;
        if (it < n_up) { convert_st(a.in[bs + off_wout(kind) + 2], 1024, 2 * FFN, (bf16_t*)(wb + WOFF_UP), it & 15, it >> 4, 1, T, sh, mod_l + 3072, sb_up, SB_UP_LD); continue; }
        it -= n_up;
        convert_st(a.in[bs + off_wout(kind) + 5], FFN, 1024, (bf16_t*)(wb + WOFF_DOWN), it % 44, it / 44, 0, T, sh, nullptr, nullptr, 0);
    }
    __syncthreads();
}

DI void phase_prenorm(const float* Xl, const float* Xc, const float* g, const float* mod_l, int scoff, bf16_t* H, float* ssq, int nrows) {
    const int lane = otid() & 63, wid = otid() >> 6, rstride = gridDim.x * 8;
    for (int row0 = blockIdx.x * 8 + wid; row0 < nrows; row0 += 4 * rstride) {
        f32x4 v[4][4];
#pragma unroll
        for (int k = 0; k < 4; ++k) {
            const int rk = row0 + k * rstride, row = rk < nrows ? rk : row0;
            const float* xr = row < MLAT ? Xl + (size_t)row * DM : Xc + (size_t)(row - MLAT) * DM;
#pragma unroll
            for (int i = 0; i < 4; ++i) v[k][i] = *(const f32x4*)(xr + i * 256 + lane * 4);
        }
#pragma unroll
        for (int k = 0; k < 4; ++k) {
            const int row = row0 + k * rstride;
            if (row < nrows) {
                const float* mp = mod_l + (size_t)(row < MLAT ? (row >> 11) : 8) * 6144;
                float ss = 0.f;
#pragma unroll
                for (int i = 0; i < 4; ++i) ss += v[k][i][0] * v[k][i][0] + v[k][i][1] * v[k][i][1] + v[k][i][2] * v[k][i][2] + v[k][i][3] * v[k][i][3];
                ss = wave_sum(ss);
                if (lane == 0) ssq[row] = ss;
#pragma unroll
                for (int i = 0; i < 4; ++i) {
                    const int c = i * 256 + lane * 4;
                    const f32x4 gg = *(const f32x4*)(g + c), sc = *(const f32x4*)(mp + scoff + c);
                    const f32x4 y = (v[k][i] * gg) * (sc + 1.0f);
                    u32x2 p; p[0] = pk2(y[0], y[1]); p[1] = pk2(y[2], y[3]);
                    *(u32x2*)(H + (size_t)row * DM + c) = p;
                }
            }
        }
    }
}
DI void phase_final_norm(const float* X, const float* g, float* out) {
    const int lane = otid() & 63, wid = otid() >> 6, rstride = gridDim.x * 8;
    f32x4 gg[4];
#pragma unroll
    for (int i = 0; i < 4; ++i) gg[i] = *(const f32x4*)(g + i * 256 + lane * 4);
    for (int row0 = blockIdx.x * 8 + wid; row0 < MLAT; row0 += 4 * rstride) {
        f32x4 v[4][4];
#pragma unroll
        for (int k = 0; k < 4; ++k) {
            const int rk = row0 + k * rstride, row = rk < MLAT ? rk : row0;
#pragma unroll
            for (int i = 0; i < 4; ++i) v[k][i] = *(const f32x4*)(X + (size_t)row * DM + i * 256 + lane * 4);
        }
#pragma unroll
        for (int k = 0; k < 4; ++k) {
            const int row = row0 + k * rstride;
            if (row < MLAT) {
                float ss = 0.f;
#pragma unroll
                for (int i = 0; i < 4; ++i) ss += v[k][i][0] * v[k][i][0] + v[k][i][1] * v[k][i][1] + v[k][i][2] * v[k][i][2] + v[k][i][3] * v[k][i][3];
                ss = wave_sum(ss);
                const float rstd = rsqrtf(ss * (1.0f / 1024.0f) + 1e-6f);
#pragma unroll
                for (int i = 0; i < 4; ++i) *(f32x4*)(out + (size_t)row * DM + i * 256 + lane * 4) = v[k][i] * rstd * gg[i];
            }
        }
    }
}

struct AttnP { const bf16_t* QKV; int pitch, qrow, qcol, kcol0, kslot, vcol, ntile, ctxrow0, latrow0, qpos, kpos0; };
constexpr float C2 = 0.125f * 1.4426950408889634f;

template <int NKT, int NDVB, bool SWA>
DI void attn_core(char* shm, const AttnP& P, f32x16 (&O)[NDVB], float& mrow, float& lrow) {
    constexpr int KB = 64 * 144, VS = 64 * NDVB + 32, VB = 64 * VS, STAGE = NKT * KB + VB, NVL = NDVB / 2, CPR = 4 * NDVB  , RPP = 512 / CPR;
    const int tid = otid(), lane = tid & 63, l31 = lane & 31, hh = lane >> 5;
    bf16x8 qf[4];
#pragma unroll
    for (int ks = 0; ks < 4; ++ks) qf[ks] = *(const bf16x8*)(P.QKV + (size_t)(P.qrow + l31) * P.pitch + P.qcol + ks * 16 + hh * 8);
    mrow = -1e30f; lrow = 0.f;
#pragma unroll
    for (int d = 0; d < NDVB; ++d) O[d] = zero16();
    const int kkey = tid >> 3, kch = tid & 7, vkey = tid / CPR, vch = tid % CPR;
    const int vtoff = (4 * hh + ((lane & 15) >> 2)) * VS + ((lane >> 4) & 1) * 32 + (lane & 3) * 8;
    u32x4 kreg[NKT], vreg[NVL];
#define ATT_GLOAD(t) do { const int r0_ = (t) < 4 ? P.ctxrow0 + 64 * (t) : P.latrow0 + 64 * ((t) - 4); \
        _Pragma("unroll") for (int c = 0; c < NKT; ++c) kreg[c] = *(const u32x4*)(P.QKV + (size_t)(r0_ + kkey) * P.pitch + P.kcol0 + c * 64 + kch * 8); \
        _Pragma("unroll") for (int j = 0; j < NVL; ++j) vreg[j] = *(const u32x4*)(P.QKV + (size_t)(r0_ + vkey + RPP * j) * P.pitch + P.vcol + vch * 8); } while (0)
    ATT_GLOAD(0);
    for (int t = 0; t < P.ntile; ++t) {
        char* base = shm + (t & 1) * STAGE;
#pragma unroll
        for (int c = 0; c < NKT; ++c) *(u32x4*)(base + c * KB + kkey * 144 + kch * 16) = kreg[c];
#pragma unroll
        for (int j = 0; j < NVL; ++j) *(u32x4*)(base + NKT * KB + (vkey + RPP * j) * VS + vch * 16) = vreg[j];
        __syncthreads();
        if (t + 1 < P.ntile) ATT_GLOAD(t + 1);
        const char* kbase = base + P.kslot * KB;
        f32x16 S[2]; S[0] = zero16(); S[1] = zero16();
        {
            bf16x8 kf[2][4];
#pragma unroll
            for (int kb = 0; kb < 2; ++kb)
#pragma unroll
                for (int ks = 0; ks < 4; ++ks) kf[kb][ks] = *(const bf16x8*)(kbase + (kb * 32 + l31) * 144 + (ks * 16 + hh * 8) * 2);
            __builtin_amdgcn_sched_barrier(0);
            __builtin_amdgcn_s_setprio(1);
#pragma unroll
            for (int ks = 0; ks < 4; ++ks)
#pragma unroll
                for (int kb = 0; kb < 2; ++kb) S[kb] = mfma32(kf[kb][ks], qf[ks], S[kb]);
            __builtin_amdgcn_s_setprio(0);
        }
        bool need_mask = false;
        if (SWA) { if (t >= 4) { const int k0 = P.kpos0 + 64 * (t - 4); need_mask = (P.qpos + 31 - k0 > 128) || (k0 + 63 - P.qpos > 128); } }
        float mx = -1e30f;
#pragma unroll
        for (int kb = 0; kb < 2; ++kb)
#pragma unroll
            for (int i = 0; i < 16; ++i) {
                if (SWA) { if (need_mask) { const int dd = (P.qpos + l31) - (P.kpos0 + 64 * (t - 4) + kb * 32 + crow(i, hh)); if (dd > 128 || dd < -128) S[kb][i] = -1e30f; } }
                mx = fmaxf(mx, S[kb][i]);
            }
        mx = fmaxf(mx, __shfl_xor(mx, 32));
        const float mnew = fmaxf(mrow, mx);
        const float mc = mnew * C2;
        float rs = 0.f;
#pragma unroll
        for (int kb = 0; kb < 2; ++kb)
#pragma unroll
            for (int i = 0; i < 16; ++i) { const float p = fexp2(__builtin_fmaf(S[kb][i], C2, -mc)); S[kb][i] = p; rs += p; }
        rs += __shfl_xor(rs, 32);
        if (__any(mnew != mrow)) {
            const float alpha = fexp2((mrow - mnew) * C2);
            lrow *= alpha;
#pragma unroll
            for (int d = 0; d < NDVB; ++d) O[d] = O[d] * alpha;
        }
        mrow = mnew;
        lrow += rs;
        {
            bf16x8 vf[2][2][NDVB];
#pragma unroll
            for (int kb = 0; kb < 2; ++kb)
#pragma unroll
                for (int s = 0; s < 2; ++s)
#pragma unroll
                    for (int d = 0; d < NDVB; ++d) {
                        const LAS char* vp = (const LAS char*)(LAS char*)(base + NKT * KB) + vtoff + (kb * 32 + s * 16) * VS + d * 64;
                        const s16x4 lo = __builtin_bit_cast(s16x4, __builtin_amdgcn_ds_read_tr16_b64_v4i16((LAS s16x4*)vp));
                        const s16x4 hi = __builtin_bit_cast(s16x4, __builtin_amdgcn_ds_read_tr16_b64_v4i16((LAS s16x4*)(vp + 8 * VS)));
                        vf[kb][s][d] = __builtin_shufflevector(lo, hi, 0, 1, 2, 3, 4, 5, 6, 7);
                    }
            bf16x8 pf[2][2];
#pragma unroll
            for (int kb = 0; kb < 2; ++kb) { pf[kb][0] = pack8(S[kb], 0); pf[kb][1] = pack8(S[kb], 1); }
            __builtin_amdgcn_sched_barrier(0);
            __builtin_amdgcn_s_setprio(1);
#pragma unroll
            for (int kb = 0; kb < 2; ++kb)
#pragma unroll
                for (int s = 0; s < 2; ++s)
#pragma unroll
                    for (int d = 0; d < NDVB; ++d) O[d] = mfma32(vf[kb][s][d], pf[kb][s], O[d]);
            __builtin_amdgcn_s_setprio(0);
        }
    }
#undef ATT_GLOAD
    __syncthreads();
}

DI void phase_da(const Args& a, char* shm, int l, bool need_ctx) {
    const bf16_t* QKV = (const bf16_t*)(a.ws + WS_QKV);
    bf16_t* ATT = (bf16_t*)(a.ws + WS_ATT);
    const float* lamp = (const float*)(a.ws + WS_ROPE) + 2048 + (l == 0 ? 0 : 2);
    const float lam = lamp[0], lam_init = lamp[1];
    const float* subg = a.in[lbase(l) + 8];
    const int lane = otid() & 63, wid = otid() >> 6, l31 = lane & 31, hh = lane >> 5;
    const int comp = wid >> 2, wq = wid & 3;
    float* xch = (float*)shm;
    const int nitem = 1024 + (need_ctx ? 128 : 0);
    for (int item = blockIdx.x; item < nitem; item += gridDim.x) {
        AttnP P; P.QKV = QKV; P.pitch = 3072; P.qpos = 0; P.kpos0 = 0;
        int b, h;
        if (item < 1024) {
            const int xcd = item & 7, j = item >> 3, qb = j & 15, bh = (j >> 4) * 8 + xcd;
            b = bh >> 3; h = bh & 7;
            P.qrow = b * 2048 + qb * 128 + wq * 32; P.ntile = 36;
        } else {
            const int i2 = item - 1024, qb = i2 & 1; h = (i2 >> 1) & 7; b = i2 >> 4;
            P.qrow = MLAT + b * 256 + qb * 128 + wq * 32; P.ntile = 4;
        }
        P.ctxrow0 = MLAT + b * 256; P.latrow0 = b * 2048;
        P.qcol = h * 128 + comp * 64; P.kcol0 = 1024 + h * 128; P.kslot = comp; P.vcol = 2048 + h * 128;
        f32x16 O[4]; float mr, lr;
        attn_core<2, 4, false>(shm, P, O, mr, lr);
        if (comp == 1) {
            const float inv1 = lam / lr;
#pragma unroll
            for (int d = 0; d < 4; ++d)
#pragma unroll
                for (int i = 0; i < 16; ++i) xch[((wq * 4 + d) * 16 + i) * 64 + lane] = O[d][i] * inv1;
        }
        __syncthreads();
        if (comp == 0) {
            const float inv0 = 1.0f / lr;
            float ss = 0.f;
#pragma unroll
            for (int d = 0; d < 4; ++d)
#pragma unroll
                for (int i = 0; i < 16; ++i) { const float o = O[d][i] * inv0 - xch[((wq * 4 + d) * 16 + i) * 64 + lane]; O[d][i] = o; ss += o * o; }
            ss += __shfl_xor(ss, 32);
            const float rstd = rsqrtf(ss * (1.0f / 128.0f) + 1e-6f) * (1.0f - lam_init);
            bf16_t* op = ATT + (size_t)(P.qrow + l31) * DM + h * 128;
#pragma unroll
            for (int d = 0; d < 4; ++d)
#pragma unroll
                for (int ig = 0; ig < 4; ++ig) {
                    const int dv = 32 * d + 8 * ig + 4 * hh;
                    const f32x4 g4 = *(const f32x4*)(subg + dv);
                    u32x2 p; p[0] = pk2(O[d][4 * ig] * rstd * g4[0], O[d][4 * ig + 1] * rstd * g4[1]);
                    p[1] = pk2(O[d][4 * ig + 2] * rstd * g4[2], O[d][4 * ig + 3] * rstd * g4[3]);
                    *(u32x2*)(op + dv) = p;
                }
        }
        __syncthreads();
    }
}

DI void phase_swa(const Args& a, char* shm, int l, bool need_ctx) {
    const bf16_t* QKV = (const bf16_t*)(a.ws + WS_QKV);
    bf16_t* ATT = (bf16_t*)(a.ws + WS_ATT);
    const float* sink = a.in[lbase(l) + 4];
    const int lane = otid() & 63, wid = otid() >> 6, l31 = lane & 31, hh = lane >> 5;
    const int nitem = 1024 + (need_ctx ? 128 : 0);
    for (int item = blockIdx.x; item < nitem; item += gridDim.x) {
        AttnP P; P.QKV = QKV; P.pitch = 1536; P.kslot = 0;
        int b, kvh;
        if (item < 1024) {
            const int xcd = item & 7, j_ = item >> 3, qb = j_ & 31, grp = (j_ >> 5) * 8 + xcd;
            kvh = grp & 3; b = grp >> 2;
            const int q0 = qb * 64, ks = q0 - 128 < 0 ? 0 : q0 - 128, ke = q0 + 192 > 2048 ? 2048 : q0 + 192;
            P.ntile = 4 + ((ke - ks) >> 6); P.latrow0 = b * 2048 + ks; P.kpos0 = ks;
            P.qpos = q0 + (wid & 1) * 32; P.qrow = b * 2048 + P.qpos;
        } else {
            const int i2 = item - 1024, j = i2 & 3; kvh = (i2 >> 2) & 3; b = i2 >> 4;
            P.ntile = 4; P.latrow0 = 0; P.kpos0 = 0; P.qpos = 0;
            P.qrow = MLAT + b * 256 + j * 64 + (wid & 1) * 32;
        }
        const int head = kvh * 4 + (wid >> 1);
        P.ctxrow0 = MLAT + b * 256;
        P.qcol = head * 64; P.kcol0 = 1024 + kvh * 64; P.vcol = 1280 + kvh * 64;
        f32x16 O[2]; float mr, lr;
        attn_core<1, 2, true>(shm, P, O, mr, lr);
        const float ltot = lr + fexp2(sink[head] * 1.4426950408889634f - mr * C2);
        const float inv = 1.0f / ltot;
        bf16_t* op = ATT + (size_t)(P.qrow + l31) * DM + head * 64;
#pragma unroll
        for (int d = 0; d < 2; ++d)
#pragma unroll
            for (int ig = 0; ig < 4; ++ig) {
                const int dv = 32 * d + 8 * ig + 4 * hh;
                u32x2 p; p[0] = pk2(O[d][4 * ig] * inv, O[d][4 * ig + 1] * inv); p[1] = pk2(O[d][4 * ig + 2] * inv, O[d][4 * ig + 3] * inv);
                *(u32x2*)(op + dv) = p;
            }
    }
}

DI int ml_row(int b, int dir, int p) { return p < 256 ? MLAT + b * 256 + (dir ? 255 - p : p) : b * 2048 + (dir ? 2047 - (p - 256) : (p - 256)); }

DI void phase_mlstm(const Args& a, char* shm) {
    const bf16_t* QKV = (const bf16_t*)(a.ws + WS_QKV);
    const float* G = (const float*)(a.ws + WS_G);
    constexpr int pitch = 3328;
    float* sA = (float*)shm; float* sB = sA + 2304; float* sM = sB + 2304; float* sN = sM + 2304;
    char* Qs = shm + 32768; char* Ks = Qs + 9216; char* KgT = Ks + 9216; char* Vt = KgT + 9216; char* Cs = Vt + 18432;
    const int tid = otid(), lane = tid & 63, wid = tid >> 6, l31 = lane & 31, hh = lane >> 5;
    const int eb = wid >> 1, tb = wid & 1;
    for (int item = blockIdx.x; item < 128; item += gridDim.x) {
        const int b = item >> 4, h = (item >> 1) & 7, dir = item & 1;
        bf16_t* HD = (bf16_t*)(a.ws + (dir ? WS_HB : WS_HF));
        __syncthreads();
        for (int p = tid; p < 2304; p += 512) {
            const int row = ml_row(b, dir, p);
            const float ig = G[(size_t)row * 32 + (2 * dir) * 8 + h], fg = G[(size_t)row * 32 + (2 * dir + 1) * 8 + h];
            sA[p] = ig; sB[p] = fminf(fg, 0.f) - log1pf(expf(-fabsf(fg)));
        }
        for (int i = tid; i < 128 * 72 / 2; i += 512) ((unsigned*)Cs)[i] = 0u;
        if (tid < 64) sN[tid] = 0.f;
        __syncthreads();
        if (wid == 0) {
            const int p0 = lane * 36;
            float s = 0.f;
            for (int i = 0; i < 36; ++i) s += sB[p0 + i];
            float incl = s;
#pragma unroll
            for (int d = 1; d < 64; d <<= 1) { const float t = __shfl_up(incl, d); if (lane >= d) incl += t; }
            float run = incl - s, mxl = -3.0e38f;
            for (int i = 0; i < 36; ++i) { run += sB[p0 + i]; const float aa = sA[p0 + i] - run; sA[p0 + i] = aa; sM[p0 + i] = run; mxl = fmaxf(mxl, aa); }
            float inclm = mxl;
#pragma unroll
            for (int d = 1; d < 64; d <<= 1) { const float t = __shfl_up(inclm, d); if (lane >= d) inclm = fmaxf(inclm, t); }
            float offm = __shfl_up(inclm, 1); if (lane == 0) offm = 0.f;
            float runm = fmaxf(offm, 0.f);
            for (int i = 0; i < 36; ++i) { runm = fmaxf(runm, sA[p0 + i]); sB[p0 + i] = runm; sM[p0 + i] += runm; }
        }
        f32x16 Cacc = zero16(); float nacc = 0.f;
        const int qs_ = tid >> 3, qch = tid & 7, ss_ = tid & 63, sch = tid >> 6;
        const int spos = (ss_ & ~12) | ((ss_ & 4) << 1) | ((ss_ & 8) >> 1);
        u32x4 qreg, kreg, vreg[2];
#define ML_GLOAD(c) do { const int rq_ = ml_row(b, dir, 64 * (c) + qs_), rs_ = ml_row(b, dir, 64 * (c) + ss_); \
        qreg = *(const u32x4*)(QKV + (size_t)rq_ * pitch + h * 64 + qch * 8); \
        kreg = *(const u32x4*)(QKV + (size_t)rs_ * pitch + 512 + h * 64 + sch * 8); \
        vreg[0] = *(const u32x4*)(QKV + (size_t)rs_ * pitch + 1024 + h * 128 + sch * 8); \
        vreg[1] = *(const u32x4*)(QKV + (size_t)rs_ * pitch + 1024 + h * 128 + (sch + 8) * 8); } while (0)
        ML_GLOAD(0);
        __syncthreads();
        for (int c = 0; c < 36; ++c) {
            const int p0 = 64 * c;
            const float Aprev = c ? sB[p0 - 1] : 0.f, Aend = sB[p0 + 63], decay = __expf(Aprev - Aend);
            *(u32x4*)(Qs + qs_ * 144 + qch * 16) = qreg;
            *(u32x4*)(Ks + ss_ * 144 + sch * 16) = kreg;
            {
                const float gs = __expf(sA[p0 + ss_] - Aend);
#pragma unroll
                for (int i = 0; i < 8; ++i) {
                    const unsigned w = kreg[i >> 1];
                    const float kv = (i & 1) ? bfhi(w) : bflo(w);
                    *(unsigned short*)(KgT + (sch * 8 + i) * 144 + spos * 2) = (unsigned short)(pk2(kv * gs, 0.f) & 0xffffu);
                }
#pragma unroll
                for (int j = 0; j < 2; ++j)
#pragma unroll
                    for (int i = 0; i < 8; ++i)
                        *(unsigned short*)(Vt + ((sch + 8 * j) * 8 + i) * 144 + spos * 2) = (unsigned short)((vreg[j][i >> 1] >> (16 * (i & 1))) & 0xffffu);
            }
            __syncthreads();
            if (c + 1 < 36) ML_GLOAD(c + 1);
            const int t = 32 * tb + l31;
            const float At = sB[p0 + t], inter = __expf(Aprev - At);
            bf16x8 qf[4];
#pragma unroll
            for (int ks = 0; ks < 4; ++ks) qf[ks] = *(const bf16x8*)(Qs + t * 144 + (ks * 16 + hh * 8) * 2);
            f32x16 S[2]; S[0] = zero16(); S[1] = zero16();
#pragma unroll
            for (int sb = 0; sb < 2; ++sb)
                if (sb <= tb) {
#pragma unroll
                    for (int ks = 0; ks < 4; ++ks) { const bf16x8 af = *(const bf16x8*)(Ks + (sb * 32 + l31) * 144 + (ks * 16 + hh * 8) * 2); S[sb] = mfma32(af, qf[ks], S[sb]); }
                }
            float colsum = 0.f;
#pragma unroll
            for (int sb = 0; sb < 2; ++sb)
                if (sb <= tb) {
#pragma unroll
                    for (int iq = 0; iq < 4; ++iq) {
                        const int s0 = 32 * sb + 8 * iq + 4 * hh;
                        const f32x4 a4 = *(const f32x4*)(sA + p0 + s0);
#pragma unroll
                        for (int j = 0; j < 4; ++j) {
                            const float w = (s0 + j <= t) ? __expf(a4[j] - At) : 0.f;
                            const float pv = S[sb][4 * iq + j] * w; S[sb][4 * iq + j] = pv; colsum += pv;
                        }
                    }
                }
            colsum += __shfl_xor(colsum, 32);
            float qn = 0.f;
#pragma unroll
            for (int j = 0; j < 4; ++j) {
                const u32x4 q8 = *(const u32x4*)(Qs + t * 144 + (32 * hh + 8 * j) * 2);
                const f32x4 n0 = *(const f32x4*)(sN + 32 * hh + 8 * j), n1 = *(const f32x4*)(sN + 32 * hh + 8 * j + 4);
                qn += bflo(q8[0]) * n0[0] + bfhi(q8[0]) * n0[1] + bflo(q8[1]) * n0[2] + bfhi(q8[1]) * n0[3] + bflo(q8[2]) * n1[0] + bfhi(q8[2]) * n1[1] + bflo(q8[3]) * n1[2] + bfhi(q8[3]) * n1[3];
            }
            qn += __shfl_xor(qn, 32);
            const float den = inter * qn + colsum, mt = sM[p0 + t];
            const float rinv = 1.0f / fmaxf(fabsf(den), __expf(-mt));
            bf16x8 vf[4];
#pragma unroll
            for (int ks = 0; ks < 4; ++ks) vf[ks] = *(const bf16x8*)(Vt + (32 * eb + l31) * 144 + (ks * 16 + hh * 8) * 2);
            f32x16 acc1 = zero16(), acc2 = zero16();
#pragma unroll
            for (int ks = 0; ks < 4; ++ks) { const bf16x8 cf = *(const bf16x8*)(Cs + (32 * eb + l31) * 144 + (ks * 16 + hh * 8) * 2); acc1 = mfma32(cf, qf[ks], acc1); }
#pragma unroll
            for (int sb = 0; sb < 2; ++sb)
                if (sb <= tb) {
#pragma unroll
                    for (int s = 0; s < 2; ++s) acc2 = mfma32(vf[2 * sb + s], pack8(S[sb], s), acc2);
                }
            {
                bf16_t* op = HD + (size_t)ml_row(b, dir, p0 + t) * DM + h * 128 + 32 * eb;
#pragma unroll
                for (int ig = 0; ig < 4; ++ig) {
                    u32x2 p; p[0] = pk2((acc1[4 * ig] * inter + acc2[4 * ig]) * rinv, (acc1[4 * ig + 1] * inter + acc2[4 * ig + 1]) * rinv);
                    p[1] = pk2((acc1[4 * ig + 2] * inter + acc2[4 * ig + 2]) * rinv, (acc1[4 * ig + 3] * inter + acc2[4 * ig + 3]) * rinv);
                    *(u32x2*)(op + 8 * ig + 4 * hh) = p;
                }
            }
            Cacc = Cacc * decay;
#pragma unroll
            for (int ks = 0; ks < 4; ++ks) { const bf16x8 kg = *(const bf16x8*)(KgT + (32 * tb + l31) * 144 + (ks * 16 + hh * 8) * 2); Cacc = mfma32(vf[ks], kg, Cacc); }
            if (wid == 0) {
                float sum = 0.f;
#pragma unroll
                for (int j = 0; j < 8; ++j) { const u32x4 k8 = *(const u32x4*)(KgT + lane * 144 + j * 16); sum += bflo(k8[0]) + bfhi(k8[0]) + bflo(k8[1]) + bfhi(k8[1]) + bflo(k8[2]) + bfhi(k8[2]) + bflo(k8[3]) + bfhi(k8[3]); }
                nacc = nacc * decay + sum;
            }
            __syncthreads();
#pragma unroll
            for (int i = 0; i < 16; ++i) *(unsigned short*)(Cs + (32 * eb + crow(i, hh)) * 144 + (32 * tb + l31) * 2) = (unsigned short)(pk2(Cacc[i], 0.f) & 0xffffu);
            if (wid == 0) sN[lane] = nacc;
        }
#undef ML_GLOAD
    }
    __syncthreads();
}

DI void phase_ml_finish(const Args& a, int l, int nrows) {
    const bf16_t* HF = (const bf16_t*)(a.ws + WS_HF); const bf16_t* HB = (const bf16_t*)(a.ws + WS_HB);
    const bf16_t* QKV = (const bf16_t*)(a.ws + WS_QKV);
    bf16_t* ATT = (bf16_t*)(a.ws + WS_ATT);
    const float* ng = a.in[lbase(l) + 5];
    const int lane = otid() & 63, wid = otid() >> 6, rstride = gridDim.x * 8, c0 = lane * 16;
    f32x4 gq[4];
#pragma unroll
    for (int q = 0; q < 4; ++q) gq[q] = *(const f32x4*)(ng + c0 + 4 * q);
    for (int row0 = blockIdx.x * 8 + wid; row0 < nrows; row0 += 3 * rstride) {
        u32x4 f[3][2], bk[3][2], o8[3][2];
#pragma unroll
        for (int k = 0; k < 3; ++k) {
            const int rk = row0 + k * rstride, row = rk < nrows ? rk : row0;
#pragma unroll
            for (int j = 0; j < 2; ++j) {
                f[k][j] = *(const u32x4*)(HF + (size_t)row * DM + c0 + 8 * j); bk[k][j] = *(const u32x4*)(HB + (size_t)row * DM + c0 + 8 * j);
                o8[k][j] = *(const u32x4*)(QKV + (size_t)row * 3328 + 2048 + c0 + 8 * j);
            }
        }
#pragma unroll
        for (int k = 0; k < 3; ++k) {
            const int row = row0 + k * rstride;
            if (row < nrows) {
                float v[16]; float ss = 0.f;
#pragma unroll
                for (int j = 0; j < 2; ++j)
#pragma unroll
                    for (int i = 0; i < 4; ++i) { v[8 * j + 2 * i] = bflo(f[k][j][i]) + bflo(bk[k][j][i]); v[8 * j + 2 * i + 1] = bfhi(f[k][j][i]) + bfhi(bk[k][j][i]); }
#pragma unroll
                for (int i = 0; i < 16; ++i) ss += v[i] * v[i];
                ss += __shfl_xor(ss, 1); ss += __shfl_xor(ss, 2); ss += __shfl_xor(ss, 4);
                const float rstd = rsqrtf(ss * (1.0f / 128.0f) + 1e-6f);
#pragma unroll
                for (int j = 0; j < 2; ++j) {
                    float y[8];
#pragma unroll
                    for (int i = 0; i < 4; ++i) {
                        const float oa = bflo(o8[k][j][i]), ob = bfhi(o8[k][j][i]);
                        const f32x4 gg = gq[2 * j + (i >> 1)];
                        const float ga = gg[2 * (i & 1)], gb = gg[2 * (i & 1) + 1];
                        y[2 * i] = v[8 * j + 2 * i] * rstd * ga / (1.f + __expf(-oa));
                        y[2 * i + 1] = v[8 * j + 2 * i + 1] * rstd * gb / (1.f + __expf(-ob));
                    }
                    u32x4 p; p[0] = pk2(y[0], y[1]); p[1] = pk2(y[2], y[3]); p[2] = pk2(y[4], y[5]); p[3] = pk2(y[6], y[7]);
                    *(u32x4*)(ATT + (size_t)row * DM + c0 + 8 * j) = p;
                }
            }
        }
    }
}

DI void phase_conv(const Args& a, int l, int half, int nrows) {
    const bf16_t* U = (const bf16_t*)(a.ws + WS_U);
    bf16_t* ACT = (bf16_t*)(a.ws + WS_ACT);
    const int kind = l % 3, bs = lbase(l);
    const float* cw = a.in[bs + off_wout(kind) + 3]; const float* cb = a.in[bs + off_wout(kind) + 4];
    const float* ssq = (const float*)(a.ws + WS_SSQ) + (size_t)(2 * l + 1) * MROWS;
    const float* sb_up = (const float*)(a.ws + WS_SB) + (size_t)l * SB_LAYER + 9 * SB_IN_LD + (half ? UP_T0 * 256 : 0);
    const int upitch = half ? (22 - UP_T0) * 256 : UP_T0 * 256, cpr = upitch >> 3, c0 = half ? UP_T0 * 128 : 0;
    const int nunits = (nrows >> 3) * cpr;
    for (int u = blockIdx.x * 512 + otid(); u < nunits; u += gridDim.x * 512) {
        const int strip = u / cpr, chunk = u - strip * cpr, r0 = strip * 8;
        const int fa = c0 + chunk * 4, uca = 256 * (chunk >> 5) + 4 * (chunk & 31);
        const int ub = r0 < MLAT ? (r0 >> 11) : 8;
        f32x4 wa[3], wg[3];
#pragma unroll
        for (int j = 0; j < 3; ++j) { wa[j] = *(const f32x4*)(cw + (size_t)j * 2 * FFN + fa); wg[j] = *(const f32x4*)(cw + (size_t)j * 2 * FFN + FFN + fa); }
        const f32x4 ba = *(const f32x4*)(cb + fa), bg = *(const f32x4*)(cb + FFN + fa);
        const f32x4 sa = *(const f32x4*)(sb_up + (size_t)ub * SB_UP_LD + uca), sg = *(const f32x4*)(sb_up + (size_t)ub * SB_UP_LD + uca + 128);
        const bool has_prev = r0 < MLAT ? (r0 & 2047) != 0 : ((r0 - MLAT) & 255) != 0;
        const int rn = r0 + 8;
        const bool has_next = rn < MLAT ? (rn & 2047) != 0 : (rn < MROWS && ((rn - MLAT) & 255) != 0);
        const bf16_t* up = U + (size_t)r0 * upitch + uca;
        u32x2 ua[10], ug[10]; float rsv[10];
#pragma unroll
        for (int i = 0; i < 10; ++i) {
            int ro = i - 1; if (i == 0 && !has_prev) ro = 0; if (i == 9 && !has_next) ro = 7;
            const bf16_t* rp = up + (ptrdiff_t)ro * upitch;
            ua[i] = *(const u32x2*)(rp); ug[i] = *(const u32x2*)(rp + 128); rsv[i] = ssq[r0 + ro];
        }
        f32x4 xa[10], xg[10];
#pragma unroll
        for (int i = 0; i < 10; ++i) {
            const float rs_ = rsqrtf(rsv[i] * (1.0f / 1024.0f) + 1e-6f);
            xa[i] = (f32x4){bflo(ua[i][0]), bfhi(ua[i][0]), bflo(ua[i][1]), bfhi(ua[i][1])} * rs_ + sa;
            xg[i] = (f32x4){bflo(ug[i][0]), bfhi(ug[i][0]), bflo(ug[i][1]), bfhi(ug[i][1])} * rs_ + sg;
        }
        const float fp = has_prev ? 1.f : 0.f, fn = has_next ? 1.f : 0.f;
        xa[0] = xa[0] * fp; xg[0] = xg[0] * fp; xa[9] = xa[9] * fn; xg[9] = xg[9] * fn;
#pragma unroll
        for (int i = 0; i < 8; ++i) {
            const f32x4 av = ba + wa[0] * xa[i] + wa[1] * xa[i + 1] + wa[2] * xa[i + 2];
            const f32x4 gv = bg + wg[0] * xg[i] + wg[1] * xg[i + 1] + wg[2] * xg[i + 2];
            float y[4];
#pragma unroll
            for (int q = 0; q < 4; ++q) y[q] = av[q] * gv[q] / (1.f + __expf(-gv[q]));
            u32x2 p; p[0] = pk2(y[0], y[1]); p[1] = pk2(y[2], y[3]);
            *(u32x2*)(ACT + (size_t)(r0 + i) * FFN + fa) = p;
        }
    }
}

DI void phase_conv_fix(const Args& a, int l, int nrows) {
    const float* EDGE = (const float*)(a.ws + WS_U);
    bf16_t* ACT = (bf16_t*)(a.ws + WS_ACT);
    const int kind = l % 3, bs = lbase(l);
    const float* cw = a.in[bs + off_wout(kind) + 3]; const float* cb = a.in[bs + off_wout(kind) + 4];
    const int nb = (nrows >> 6) - 1, total = nb * 704;
    for (int u = blockIdx.x * 512 + otid(); u < total; u += gridDim.x * 512) {
        const int bb = u / 704, ch = (u - bb * 704) * 4, r = 64 * (bb + 1);
        const bool interior = r < MLAT ? (r & 2047) != 0 : ((r - MLAT) & 255) != 0;
        if (!interior) continue;
        const float* eA = EDGE + ((size_t)(bb * 4 + 2) * 2) * FFN + ch;
        const float* eB = eA + 2 * FFN;
        const float* eC = EDGE + ((size_t)((bb + 1) * 4) * 2) * FFN + ch;
        const float* eD = eC + 2 * FFN;
        f32x4 wa[3], wg[3];
#pragma unroll
        for (int j = 0; j < 3; ++j) { wa[j] = *(const f32x4*)(cw + (size_t)j * 2 * FFN + ch); wg[j] = *(const f32x4*)(cw + (size_t)j * 2 * FFN + FFN + ch); }
        const f32x4 ba = *(const f32x4*)(cb + ch), bg = *(const f32x4*)(cb + FFN + ch);
        const f32x4 aA = *(const f32x4*)(eA), gA = *(const f32x4*)(eA + FFN), aB = *(const f32x4*)(eB), gB = *(const f32x4*)(eB + FFN);
        const f32x4 aC = *(const f32x4*)(eC), gC = *(const f32x4*)(eC + FFN), aD = *(const f32x4*)(eD), gD = *(const f32x4*)(eD + FFN);
        const f32x4 a1 = ba + wa[0] * aA + wa[1] * aB + wa[2] * aC, g1 = bg + wg[0] * gA + wg[1] * gB + wg[2] * gC;
        const f32x4 a2 = ba + wa[0] * aB + wa[1] * aC + wa[2] * aD, g2 = bg + wg[0] * gB + wg[1] * gC + wg[2] * gD;
        float y[4], z[4];
#pragma unroll
        for (int q = 0; q < 4; ++q) { y[q] = a1[q] * g1[q] / (1.f + __expf(-g1[q])); z[q] = a2[q] * g2[q] / (1.f + __expf(-g2[q])); }
        u32x2 p; p[0] = pk2(y[0], y[1]); p[1] = pk2(y[2], y[3]);
        *(u32x2*)(ACT + (size_t)(r - 1) * FFN + ch) = p;
        p[0] = pk2(z[0], z[1]); p[1] = pk2(z[2], z[3]);
        *(u32x2*)(ACT + (size_t)r * FFN + ch) = p;
    }
}

#define XB_TMO      128
#define XB_XCNT(j)  (256  + 64 * (j))
#define XB_XSUB(j)  (1280 + 64 * (j))
#define XB_XGEN(j)  (2304 + 64 * (j))
#define XB_TOP      3328
#define XB_TOPGEN   3392
#define XCD_BAR_WORDS 3456
#define XB_SPIN_CAP (1u << 18)

__device__ __forceinline__ unsigned xb_ld(unsigned* p)              { return __hip_atomic_load(p, __ATOMIC_RELAXED, __HIP_MEMORY_SCOPE_AGENT); }
__device__ __forceinline__ unsigned xb_add(unsigned* p, unsigned v) { return __hip_atomic_fetch_add(p, v, __ATOMIC_RELAXED, __HIP_MEMORY_SCOPE_AGENT); }
__device__ __forceinline__ unsigned xb_xcc_id() { return (unsigned)__builtin_amdgcn_s_getreg((3 << 11) | 20) & 0xFu; }
#define XB_SPIN(cond, bar) do { unsigned _sp = 0; while (cond) { __builtin_amdgcn_s_sleep(1); \
    if ((++_sp & 255u) == 0u) { if (xb_ld(&(bar)[XB_TMO])) break; if (_sp > XB_SPIN_CAP) { atomicAdd(&(bar)[XB_TMO], 1u); break; } } } } while (0)

struct XcdBarrier {
    unsigned* bar; unsigned x;
    volatile LAS unsigned* st;
};

__device__ __forceinline__ XcdBarrier xcd_barrier_post(unsigned* bar, volatile LAS unsigned* st) {
    XcdBarrier b; b.bar = bar; b.x = xb_xcc_id(); b.st = st;
    if (otid() == 0) (void)xb_add(&bar[XB_XCNT(b.x)], 1u);
    return b;
}
__device__ __forceinline__ void xcd_barrier_complete(unsigned* bar, unsigned x, unsigned& nloc, unsigned& nx) {
    const unsigned G = gridDim.x * gridDim.y * gridDim.z;
    unsigned sum, cnt, mine, sp = 0u;
    for (;;) {
        sum = 0u; cnt = 0u; mine = 0u;
#pragma unroll
        for (unsigned j = 0; j < 16; ++j) { const unsigned c = xb_ld(&bar[XB_XCNT(j)]); sum += c; cnt += (c > 0u) ? 1u : 0u; mine = (j == x) ? c : mine; }
        if (sum == G) break;
        __builtin_amdgcn_s_sleep(1);
        if ((++sp & 255u) == 0u) { if (xb_ld(&bar[XB_TMO])) break; if (sp > XB_SPIN_CAP) { atomicAdd(&bar[XB_TMO], 1u); break; } }
    }
    nloc = mine > 0u ? mine : 1u; nx = cnt > 0u ? cnt : 1u;
}

__device__ __forceinline__ void xcd_barrier(const XcdBarrier& b) {
    asm volatile("s_waitcnt vmcnt(0)" ::: "memory");
    __syncthreads();
    if (otid() == 0) {
        unsigned* bar = b.bar;
        __builtin_amdgcn_s_waitcnt(0);
        unsigned nloc = b.st[0], nx = b.st[1];
        if (nloc == 0u) { xcd_barrier_complete(bar, b.x, nloc, nx); b.st[0] = nloc; b.st[1] = nx; }
        const unsigned old = xb_add(&bar[XB_XSUB(b.x)], 1u);
        const unsigned gen = old / nloc;
        if (old + 1u == (gen + 1u) * nloc) {
            __builtin_amdgcn_fence(__ATOMIC_RELEASE, "agent");
            asm volatile("s_waitcnt vmcnt(0)" ::: "memory");
            const unsigned og = xb_add(&bar[XB_TOP], 1u);
            const unsigned tg = og / nx;
            if (og + 1u == (tg + 1u) * nx) xb_add(&bar[XB_TOPGEN], 1u);
            else XB_SPIN(xb_ld(&bar[XB_TOPGEN]) == tg, bar);
            __builtin_amdgcn_fence(__ATOMIC_ACQUIRE, "agent");
            xb_add(&bar[XB_XGEN(b.x)], 1u);
            asm volatile("s_waitcnt vmcnt(0)" ::: "memory");
        } else {
            XB_SPIN(xb_ld(&bar[XB_XGEN(b.x)]) == gen, bar);
            __builtin_amdgcn_fence(__ATOMIC_ACQUIRE, "agent");
            asm volatile("s_waitcnt vmcnt(0)" ::: "memory");
        }
    }
    __syncthreads();
}

__host__ __device__ inline bool phase_active(int ph) {
    if (ph == 0 || ph == 45) return true;
    const int l = (ph - 1) / 11, s = (ph - 1) % 11;
    if (s == 3) return (l % 3) == 1;
    if (s == 5 || s == 8 || s == 9) return false;
    if (s == 0) return l == 0;
    return true;
}

DI void run_phase(const Args& a, char* shm, int ph) {
    if (ph == 0) { phase_prologue(a, shm); return; }
    float* X = (float*)(a.ws + WS_X);
    if (ph == 45) { phase_final_norm(X, a.in[57], a.out); return; }
    const int l = (ph - 1) / 11, s = (ph - 1) % 11, kind = l % 3, bs = lbase(l);
    const bool need_ctx = l < 3;
    const int Mff = need_ctx ? MROWS : MLAT;
    const float* mod_l = (const float*)(a.ws + WS_MOD) + (size_t)l * 9 * 6144;
    const float* Xl = l == 0 ? a.in[0] : X; const float* Xc = l == 0 ? a.in[2] : X + (size_t)MLAT * DM;
    bf16_t* H = (bf16_t*)(a.ws + WS_H);
    unsigned char* wb = a.ws + WS_W;
    float* ssq1 = (float*)(a.ws + WS_SSQ) + (size_t)(2 * l) * MROWS; float* ssq2 = ssq1 + MROWS;
    const float* sb_in = (const float*)(a.ws + WS_SB) + (size_t)l * SB_LAYER; const float* sb_up = sb_in + 9 * SB_IN_LD;
    if (s == 1 || s == 4 || s == 6 || s == 8 || s == 10) {
        Epi E; E.mode = 0; E.O = nullptr; E.ldo = 0; E.ropelim = 0; E.ropec = (const float*)(a.ws + WS_ROPE); E.ropes = E.ropec + 1024;
        E.G = (float*)(a.ws + WS_G); E.gate_b = nullptr; E.X = X; E.res_lat = nullptr; E.res_ctx = nullptr; E.gate = nullptr;
        E.ssq_in = nullptr; E.sbias = nullptr; E.sb_ld = 0; E.Hout = nullptr; E.hgain = (const float*)(a.ws + WS_HG); E.ssq_out = nullptr;
        E.cw = nullptr; E.cb = nullptr; E.ACT = nullptr; E.EDGE = nullptr;
        const bf16_t* A = H; const bf16_t* Bt = (const bf16_t*)(wb + WOFF_IN); int M = MROWS, N = 1024, K = 1024;
        if (s == 1) {
            E.O = (bf16_t*)(a.ws + WS_QKV); E.ldo = ninpad_of(kind); N = ninpad_of(kind);
            E.ssq_in = ssq1; E.sbias = sb_in; E.sb_ld = SB_IN_LD;
            if (kind == 0) { E.ropelim = 2048; } else if (kind == 1) { E.mode = 1; E.gate_b = a.in[bs + 4]; } else { E.ropelim = 1280; }
        } else if (s == 4) {
            E.mode = 2; E.res_lat = Xl; E.res_ctx = Xc; E.gate = mod_l + 2048;
            E.Hout = H; E.hgain = (const float*)(a.ws + WS_HG) + (size_t)((4 + l) * 9) * 1024; E.ssq_out = ssq2;
            A = (const bf16_t*)(a.ws + WS_ATT); Bt = (const bf16_t*)(wb + WOFF_OUT); M = Mff;
        } else if (s == 10) {
            E.mode = 2; E.res_lat = X; E.res_ctx = X + (size_t)MLAT * DM; E.gate = mod_l + 5120;
            if (l < 3) { E.Hout = H; E.hgain = (const float*)(a.ws + WS_HG) + (size_t)((l + 1) * 9) * 1024; E.ssq_out = ssq1 + 2 * MROWS; }
            A = (const bf16_t*)(a.ws + WS_ACT); Bt = (const bf16_t*)(wb + WOFF_DOWN); M = Mff; K = FFN;
        } else {
            E.mode = 4; N = 2 * FFN; M = Mff;
            E.ssq_in = ssq2; E.sbias = sb_up; E.sb_ld = SB_UP_LD;
            E.cw = a.in[bs + off_wout(kind) + 3]; E.cb = a.in[bs + off_wout(kind) + 4]; E.ACT = (bf16_t*)(a.ws + WS_ACT); E.EDGE = (float*)(a.ws + WS_U);
            Bt = (const bf16_t*)(wb + WOFF_UP);
        }
        if (s == 1 && kind != 1) {
            float* rl = (float*)(shm + 131072 + 1024 + 10240);
            for (int i = otid(); i < 2048; i += 512) rl[i] = E.ropec[i];
            __syncthreads();
        }
        run_gemm(shm, A, Bt, M, N, K, E);
        {
            int cl = -1, which = 0;
            if (s == 1 && l >= 1) { cl = l; which = 8; }
            else if (s == 4 && l <= 2) { cl = l + 1; which = 1; }
            else if (s == 10 && l <= 2) { cl = l + 1; which = 6; }
            if (cl >= 0) {
                const int nwg = (M >> 8) * (N >> 8), G = (int)gridDim.x, rem = nwg % G, c = (int)blockIdx.x;
                if (rem == 0) phase_convert(a, shm, cl, which, c, G);
                else if (c >= rem) phase_convert(a, shm, cl, which, c - rem, G - rem);
            }
        }
        return;
    }
    switch (s) {
    case 0:
        phase_convert(a, shm, 0, 15, (int)blockIdx.x, (int)gridDim.x);
        {
            float* HG = (float*)(a.ws + WS_HG); const float* modb = (const float*)(a.ws + WS_MOD);
            for (int i = blockIdx.x * 512 + otid(); i < 2 * 4 * 9 * 1024; i += gridDim.x * 512) {
                const int c = i & 1023, rb = (i >> 10) % 9, tl = i / (9 * 1024), ll = tl & 3, t = tl >> 2, kk = ll % 3;
                const float g = t ? a.in[lbase(ll) + off_wout(kk) + 1][c] : a.in[lbase(ll) + 2][c];
                HG[i] = g * (1.0f + modb[(size_t)(ll * 9 + rb) * 6144 + (t ? 4096 : 1024) + c]);
            }
        }
        phase_prenorm(Xl, Xc, a.in[bs + 2], mod_l, 1024, H, ssq1, MROWS);
        break;
    case 2:
#ifndef NO_DA
        if (kind == 0) phase_da(a, shm, l, need_ctx);
#endif
#ifndef NO_ML
        if (kind == 1) phase_mlstm(a, shm);
#endif
#ifndef NO_SWA
        if (kind == 2) phase_swa(a, shm, l, need_ctx);
#endif
        break;
    case 3:
        phase_ml_finish(a, l, Mff);
        break;
    case 7:
        phase_conv_fix(a, l, Mff);
        break;
    }
}

__global__ void __launch_bounds__(512, 2) mega_fwd(Args a) {
    extern __shared__ __attribute__((aligned(16))) char shm[];
    volatile LAS unsigned* st = (volatile LAS unsigned*)((LAS char*)shm + 131072 + 256);
    if (otid() == 0) { st[0] = 0u; st[1] = 0u; }
    __syncthreads();
    XcdBarrier xb = xcd_barrier_post((unsigned*)(a.ws + WS_BAR), st);
    for (int ph = a.ph_lo; ph < a.ph_hi; ++ph) {
        if (!phase_active(ph)) continue;
        int reps = 1;
#ifdef PROBE_REP
        if (ph > 0 && ph < 45) {
            const int l_ = (ph - 1) / 11, s_ = (ph - 1) % 11, k_ = l_ % 3;
            bool rep = false;
            if (PROBE_REP == 1) rep = (s_ == 1);
            if (PROBE_REP == 2) rep = (s_ == 6);
            if (PROBE_REP == 3) rep = (s_ == 2 && k_ == 0);
            if (PROBE_REP == 4) rep = (s_ == 2 && k_ != 0) || s_ == 3;
            if (PROBE_REP == 5) rep = (s_ == 7);
            if (rep) reps = 2;
        }
#endif
        for (int r = 0; r < reps; ++r) {
            run_phase(a, shm, ph);
            if (a.use_sync && (ph + 1 < a.ph_hi || r + 1 < reps)) {
                if (a.use_sync == 2) cg::this_grid().sync();
                xcd_barrier(xb);
            }
        }
    }
}

extern "C" void kernel_launch(void* const* d_in, const int* in_sizes, int n_in, void* d_out, int out_size, void* d_ws, size_t ws_size, hipStream_t stream) {
    static int grid_blocks = 0;
    if (!grid_blocks) {
        int dev = 0, cus = 0, per_cu = 0;
        hipGetDevice(&dev);
        hipDeviceGetAttribute(&cus, hipDeviceAttributeMultiprocessorCount, dev);
        hipFuncSetAttribute((const void*)mega_fwd, hipFuncAttributeMaxDynamicSharedMemorySize, LDS_BYTES);
        hipOccupancyMaxActiveBlocksPerMultiprocessor(&per_cu, mega_fwd, 512, LDS_BYTES);
        if (per_cu < 1) { fprintf(stderr, "occupancy query returned %d\n", per_cu); per_cu = 1; }
        grid_blocks = cus * 1;
    }
    Args a{};
    for (int i = 0; i < 58; ++i) a.in[i] = (const float*)d_in[i];
    a.out = (float*)d_out; a.ws = (unsigned char*)d_ws; a.pad = 0;
#if MK_ONE_LAUNCH
    a.ph_lo = 0; a.ph_hi = NPHASE; a.use_sync = 1;
    hipMemsetAsync((char*)d_ws + WS_BAR, 0, ZERO_BYTES, stream);
    void* args[] = {&a};
    hipError_t e = hipLaunchCooperativeKernel((const void*)mega_fwd, dim3(grid_blocks), dim3(512), args, LDS_BYTES, stream);
    if (e != hipSuccess) fprintf(stderr, "cooperative launch failed: %s (grid %d)\n", hipGetErrorString(e), grid_blocks);
#else
    a.use_sync = 0;
    for (int ph = 0; ph < NPHASE; ++ph) {
        if (!phase_active(ph)) continue;
        a.ph_lo = ph; a.ph_hi = ph + 1;
        hipLaunchKernelGGL(mega_fwd, dim3(grid_blocks), dim3(512), LDS_BYTES, stream, a);
    }
#endif
}
```

```cpp
#include <hip/hip_runtime.h>
#include <hip/hip_cooperative_groups.h>
#include <cstdio>
#include <type_traits>
namespace cg = cooperative_groups;

#ifndef MK_ONE_LAUNCH
#define MK_ONE_LAUNCH 1
#endif

#define DI __device__ __forceinline__
typedef float f32x2 __attribute__((ext_vector_type(2)));
typedef float f32x16 __attribute__((ext_vector_type(16)));
typedef unsigned u32x2 __attribute__((ext_vector_type(2)));
typedef short s16x4 __attribute__((ext_vector_type(4)));
typedef __bf16 bf16x2_t __attribute__((ext_vector_type(2)));

namespace pg8 {
#define PG8_LAS __attribute__((address_space(3)))
typedef unsigned short bf16_t;
typedef short bf16x8 __attribute__((ext_vector_type(8)));
typedef float f32x4 __attribute__((ext_vector_type(4)));
typedef unsigned u32x4 __attribute__((ext_vector_type(4)));
constexpr int BM = 256, BK = 64, HALF = 128, HTB = HALF * BK * 2  , STAGE_BYTES = 8 * HTB, NXCD = 8, WGM = 8;

__host__ __device__ __forceinline__ int lds_byte(int r, int c) { const int st = (r >> 4) * 2 + (c >> 5), rr = r & 15, cc = c & 31, ob = rr * 64 + cc * 2; return st * 1024 + (ob ^ (((ob >> 9) & 1) << 5)); }
__host__ __device__ __forceinline__ void stage_rc(int b, int& R, int& C) { const int st = b / 1024, sb = b % 1024, swz = sb ^ (((sb >> 9) & 1) << 5); R = (st >> 1) * 16 + swz / 64; C = (st & 1) * 32 + (swz % 64) / 2; }
__host__ __device__ __forceinline__ int perm32(int rho) { const int n = rho >> 4, i = rho & 15; return 8 * (i >> 2) + 4 * n + (i & 3); }

struct Unit { int pm, pn; };
struct Gemm { const bf16_t* A; const bf16_t* Bt; int M, N, K; };

struct StaticOrder {
    int nM, nN, nwg, G, c;
    __host__ __device__ void init(int M, int N, int G_, int c_) { nM = M / BM; nN = N / BM; nwg = nM * nN; G = G_; c = c_; }
    __host__ __device__ bool next(int i, Unit& u) const {
        const long L = (long)i * G + c; if (L >= nwg) return false;
        int wgid = (int)L; { const int q = nwg / NXCD, r = nwg % NXCD, xcd = wgid % NXCD, off = wgid / NXCD; wgid = (xcd < r ? xcd * (q + 1) : r * (q + 1) + (xcd - r) * q) + off; }
        const int nig = WGM * nN, gid = wgid / nig, fm = gid * WGM, gsz = (nM - fm) < WGM ? (nM - fm) : WGM;
        u.pm = fm + ((wgid % nig) % gsz); u.pn = (wgid % nig) / gsz; return true;
    }
    __device__ __forceinline__ void a_ready(const Unit&) const {}
    __device__ __forceinline__ void done(const Unit&) const {}
};

template <class Epi, class Sched>
__device__ __forceinline__ void gemm_phase(PG8_LAS unsigned char* lds, const Gemm g, const Sched& S, const Epi& E) {
    int tid = threadIdx.x; asm volatile("" : "+v"(tid)); const int wid = __builtin_amdgcn_readfirstlane(tid >> 6), wr = wid >> 2, wc = wid & 3;
    const int K = g.K, nt = K / BK;
    const size_t kstep = (size_t)(BK * 2);
    const size_t hstep = (size_t)HALF * K * 2;
    const size_t tstep = 2 * hstep;
    const unsigned ldsw = (unsigned)wid * 1024u;
    unsigned voffA[2], voffB[2]; int aoff, boff;
#define PG8_DERIVE() do { int t_ = tid; asm volatile("" : "+v"(t_)); const int ln_ = t_ & 63, fr_ = ln_ & 15, fq_ = ln_ >> 4; \
        _Pragma("unroll") for (int i = 0; i < 2; ++i) { int R, C; stage_rc(t_ * 16 + i * 8192, R, C); const int Rb = Epi::PERM ? ((R & ~31) + perm32(R & 31)) : R; \
            voffA[i] = (unsigned)(R * K + C) * 2u; voffB[i] = (unsigned)(Rb * K + C) * 2u; } \
        aoff = lds_byte(wr * 64 + fr_, fq_ * 8); boff = lds_byte(wc * 32 + fr_, fq_ * 8); } while (0)
    PG8_DERIVE();
#define PG8_SA(b, h) (((b) * 2 + (h)) * HTB)
#define PG8_SB(b, h) ((4 + (b) * 2 + (h)) * HTB)
#define PG8_STAGE(bufoff, gbase, voff) do { _Pragma("unroll") for (int _i = 0; _i < 2; ++_i) \
        __builtin_amdgcn_global_load_lds((const unsigned*)((const char*)(gbase) + (voff)[_i]), (PG8_LAS unsigned*)(lds + (bufoff) + ldsw + _i * 8192), 16, 0, 0); } while (0)
#define PG8_LDA(dst, b, h) do { _Pragma("unroll") for (int m = 0; m < 4; ++m) _Pragma("unroll") for (int k = 0; k < 2; ++k) dst[m][k] = *(const PG8_LAS bf16x8*)(lds + PG8_SA(b, h) + aoff + m * 2048 + k * 1024); } while (0)
#define PG8_LDB(dst, b, h) do { _Pragma("unroll") for (int n = 0; n < 2; ++n) _Pragma("unroll") for (int k = 0; k < 2; ++k) dst[n][k] = *(const PG8_LAS bf16x8*)(lds + PG8_SB(b, h) + boff + n * 2048 + k * 1024); } while (0)
#define PG8_MMA(ai, bj, At, Bt) do { __builtin_amdgcn_s_setprio(1); _Pragma("unroll") for (int m = 0; m < 4; ++m) _Pragma("unroll") for (int n = 0; n < 2; ++n) _Pragma("unroll") for (int k = 0; k < 2; ++k) \
        acc[ai][bj][m][n] = __builtin_amdgcn_mfma_f32_16x16x32_bf16(Bt[n][k], At[m][k], acc[ai][bj][m][n], 0, 0, 0); __builtin_amdgcn_s_setprio(0); } while (0)
#define PG8_WAIT_V(n) asm volatile("s_waitcnt vmcnt(" #n ")" ::: "memory")
#define PG8_WAIT_L(n) asm volatile("s_waitcnt lgkmcnt(" #n ")" ::: "memory")
#define PG8_BAR __builtin_amdgcn_s_barrier()
#define PG8_SCHED __builtin_amdgcn_sched_barrier(0)
    Unit cur, nxt; int ui = 0;
    if (!S.next(0, cur)) return;
    f32x4 acc[2][2][4][2];
#pragma unroll
    for (int a = 0; a < 2; ++a)
#pragma unroll
        for (int b = 0; b < 2; ++b)
#pragma unroll
            for (int m = 0; m < 4; ++m)
#pragma unroll
                for (int n = 0; n < 2; ++n) acc[a][b][m][n] = (f32x4){0.f, 0.f, 0.f, 0.f};
    bf16x8 At[4][2], B0[2][2], B1[2][2];
    const char* cA = (const char*)g.A + (size_t)cur.pm * tstep; const char* cB = (const char*)g.Bt + (size_t)cur.pn * tstep;
    S.a_ready(cur);
    PG8_STAGE(PG8_SB(0, 0), cB, voffB); PG8_STAGE(PG8_SA(0, 0), cA, voffA); PG8_STAGE(PG8_SB(0, 1), cB + hstep, voffB); PG8_STAGE(PG8_SA(0, 1), cA + hstep, voffA);
    if (wr == 1) PG8_BAR;
    PG8_WAIT_V(4); PG8_BAR;
    PG8_STAGE(PG8_SB(1, 0), cB + kstep, voffB); PG8_STAGE(PG8_SA(1, 0), cA + kstep, voffA); PG8_STAGE(PG8_SB(1, 1), cB + hstep + kstep, voffB);
    PG8_WAIT_V(6); PG8_BAR;
    for (;;) {
        const bool has_next = S.next(ui + 1, nxt);
        const char* nA = has_next ? (const char*)g.A + (size_t)nxt.pm * tstep : cA; const char* nB = has_next ? (const char*)g.Bt + (size_t)nxt.pn * tstep : cB;
        for (int t = 0; t < nt; t += 2) {
            const bool last = (t == nt - 2);
            const char* a1 = cA + (size_t)(t + 1) * kstep;
            const char* a2 = last ? nA : cA + (size_t)(t + 2) * kstep; const char* b2 = last ? nB : cB + (size_t)(t + 2) * kstep;
            const char* a3 = a2 + kstep; const char* b3 = b2 + kstep;
            if (last && has_next) S.a_ready(nxt);
            PG8_LDB(B0, 0, 0); PG8_SCHED; PG8_LDA(At, 0, 0); PG8_STAGE(PG8_SA(1, 1), a1 + hstep, voffA);
            PG8_WAIT_L(8); PG8_BAR; PG8_WAIT_L(0); PG8_MMA(0, 0, At, B0); PG8_BAR; PG8_SCHED;
            PG8_LDB(B1, 0, 1); PG8_STAGE(PG8_SB(0, 0), b2, voffB);
            PG8_BAR; PG8_WAIT_L(0); PG8_MMA(0, 1, At, B1); PG8_BAR;
            PG8_LDA(At, 0, 1); PG8_STAGE(PG8_SA(0, 0), a2, voffA);
            PG8_BAR; PG8_WAIT_L(0); PG8_MMA(1, 0, At, B0); PG8_BAR; PG8_SCHED;
            PG8_STAGE(PG8_SB(0, 1), b2 + hstep, voffB);
            PG8_WAIT_V(6); PG8_BAR; PG8_MMA(1, 1, At, B1); PG8_BAR;
            PG8_LDB(B0, 1, 0); PG8_SCHED; PG8_LDA(At, 1, 0); PG8_STAGE(PG8_SA(0, 1), a2 + hstep, voffA);
            PG8_WAIT_L(8); PG8_BAR; PG8_WAIT_L(0); PG8_MMA(0, 0, At, B0); PG8_BAR; PG8_SCHED;
            PG8_LDB(B1, 1, 1); PG8_STAGE(PG8_SB(1, 0), b3, voffB);
            PG8_BAR; PG8_WAIT_L(0); PG8_MMA(0, 1, At, B1); PG8_BAR;
            PG8_LDA(At, 1, 1); PG8_STAGE(PG8_SA(1, 0), a3, voffA);
            PG8_BAR; PG8_WAIT_L(0); PG8_MMA(1, 0, At, B0); PG8_BAR; PG8_SCHED;
            PG8_STAGE(PG8_SB(1, 1), b3 + hstep, voffB);
            PG8_WAIT_V(6); PG8_BAR; PG8_MMA(1, 1, At, B1); PG8_BAR;
        }
        if constexpr (!Epi::AFTER_DRAIN) { { int t_ = tid; asm volatile("" : "+v"(t_)); const int ln_ = t_ & 63; E(acc, cur, wr, wc, ln_ & 15, ln_ >> 4); } S.done(cur); PG8_DERIVE(); }
        if (!has_next) break;
#pragma unroll
        for (int a = 0; a < 2; ++a)
#pragma unroll
            for (int b = 0; b < 2; ++b)
#pragma unroll
                for (int m = 0; m < 4; ++m)
#pragma unroll
                    for (int n = 0; n < 2; ++n) acc[a][b][m][n] = (f32x4){0.f, 0.f, 0.f, 0.f};
        cur = nxt; cA = nA; cB = nB; ++ui;
    }
    PG8_WAIT_V(0);
    if (wr == 0) PG8_BAR;
    PG8_BAR;
    if constexpr (Epi::AFTER_DRAIN) { const int lane = tid & 63; E.fused(acc, cur, wr, wc, lane & 15, lane >> 4, lds, wid, lane); S.done(cur); }
#undef PG8_SA
#undef PG8_DERIVE
#undef PG8_SB
#undef PG8_STAGE
#undef PG8_LDA
#undef PG8_LDB
#undef PG8_MMA
#undef PG8_WAIT_V
#undef PG8_WAIT_L
#undef PG8_BAR
#undef PG8_SCHED
}
}

using pg8::bf16_t; using pg8::bf16x8; using pg8::f32x4; using pg8::u32x4;
#define LAS __attribute__((address_space(3)))
DI int otid() { int t = threadIdx.x; asm volatile("" : "+v"(t)); return t; }

constexpr int MROWS = 18432, MLAT = 16384, DM = 1024, FFN = 2816, FH = 1408;
constexpr size_t MiB = 1u << 20;
constexpr size_t WS_X = 0, WS_W = 72 * MiB, WS_H = 97 * MiB, WS_QKV = 133 * MiB, WS_U = 133 * MiB, WS_ACT = 241 * MiB,
                 WS_ATT = 250 * MiB, WS_HF = 286 * MiB, WS_HB = WS_H, WS_G = 322 * MiB, WS_MOD = 340 * MiB, WS_ROPE = 341 * MiB, WS_BAR = 342 * MiB, WS_SSQ = 343 * MiB, WS_SB = 344 * MiB, WS_HG = 349 * MiB;
constexpr int UP_T0 = 12;
constexpr int SB_IN_LD = 3328, SB_UP_LD = 5632;
constexpr size_t SB_LAYER = (size_t)9 * (SB_IN_LD + SB_UP_LD);
constexpr size_t ZERO_BYTES = 4 * MiB;
constexpr size_t WOFF_IN = 0, WOFF_OUT = 13 * MiB / 2, WOFF_UP = 17 * MiB / 2, WOFF_DOWN = 39 * MiB / 2;
constexpr int LDS_BYTES = 151552;
constexpr int NPHASE = 46;

struct Args { const float* in[58]; float* out; unsigned char* ws; int ph_lo, ph_hi, use_sync, pad; };

DI int lbase(int l) { return l == 0 ? 4 : l == 1 ? 19 : l == 2 ? 31 : 42; }
DI int off_wout(int k) { return k == 0 ? 9 : k == 1 ? 6 : 5; }
DI int nin_of(int k) { return k == 0 ? 3072 : k == 1 ? 3104 : 1536; }
DI int ninpad_of(int k) { return k == 0 ? 3072 : k == 1 ? 3328 : 1536; }

DI unsigned pk2(float lo, float hi) { f32x2 v = {lo, hi}; bf16x2_t b = __builtin_convertvector(v, bf16x2_t); return __builtin_bit_cast(unsigned, b); }
DI float bflo(unsigned u) { return __uint_as_float(u << 16); }
DI float bfhi(unsigned u) { return __uint_as_float(u & 0xffff0000u); }
DI f32x16 mfma32(bf16x8 a, bf16x8 b, f32x16 c) { return __builtin_amdgcn_mfma_f32_32x32x16_bf16(a, b, c, 0, 0, 0); }
DI int crow(int i, int h) { return (i & 3) + 8 * (i >> 2) + 4 * h; }
DI float fexp2(float x) { return __builtin_amdgcn_exp2f(x); }
DI float wave_sum(float v) {
#pragma unroll
    for (int d = 32; d >= 1; d >>= 1) v += __shfl_xor(v, d);
    return v;
}
DI f32x16 zero16() { f32x16 z;
#pragma unroll
    for (int i = 0; i < 16; ++i) z[i] = 0.f; return z; }
DI bf16x8 pack8(const f32x16& x, int s) {
    u32x4 p; p[0] = pk2(x[8 * s], x[8 * s + 1]); p[1] = pk2(x[8 * s + 2], x[8 * s + 3]); p[2] = pk2(x[8 * s + 4], x[8 * s + 5]); p[3] = pk2(x[8 * s + 6], x[8 * s + 7]);
    return __builtin_bit_cast(bf16x8, p);
}

struct Epi {
    static constexpr bool PERM = false, AFTER_DRAIN = false;
    int mode;
    bf16_t* O; int ldo; int ropelim;
    const float* ropec; const float* ropes;
    float* G; const float* gate_b;
    float* X; const float* res_lat; const float* res_ctx; const float* gate;
    const float* ssq_in; const float* sbias;
    int sb_ld;
    bf16_t* Hout; const float* hgain; float* ssq_out;
    const float* cw; const float* cb; bf16_t* ACT; float* EDGE;
    __device__ __forceinline__ void operator()(const f32x4 (&acc)[2][2][4][2], const pg8::Unit& u, int wr, int wc, int fr, int fq) const {
        const int row0 = u.pm * 256 + wr * 64 + fr, col0 = u.pn * 256 + wc * 32 + 4 * fq;
#ifdef EPI_ONLY
        if (EPI_ONLY == 2) {
#else
        if (mode == 2) {
#endif
            const int ub = u.pm < 64 ? (u.pm >> 3) : 8;
            const float* gp = gate + (size_t)ub * 6144;
            f32x4 gv[2][2], hg[2][2];
#pragma unroll
            for (int bj = 0; bj < 2; ++bj)
#pragma unroll
                for (int n = 0; n < 2; ++n) {
                    const int c = col0 + bj * 128 + n * 16;
                    gv[bj][n] = *(const f32x4*)(gp + c);
                    hg[bj][n] = *(const f32x4*)(hgain + (size_t)ub * 1024 + c);
                }
#pragma unroll
            for (int ai = 0; ai < 2; ++ai)
#pragma unroll
                for (int mp = 0; mp < 2; ++mp) {
                    f32x4 rv[2][2][2];
#pragma unroll
                    for (int mm = 0; mm < 2; ++mm) {
                        const int r = row0 + ai * 128 + (2 * mp + mm) * 16;
                        const float* rp = r < MLAT ? res_lat + (size_t)r * DM : res_ctx + (size_t)(r - MLAT) * DM;
#pragma unroll
                        for (int bj = 0; bj < 2; ++bj)
#pragma unroll
                            for (int n = 0; n < 2; ++n) rv[mm][bj][n] = *(const f32x4*)(rp + col0 + bj * 128 + n * 16);
                    }
#pragma unroll
                    for (int mm = 0; mm < 2; ++mm) {
                        const int m = 2 * mp + mm, r = row0 + ai * 128 + m * 16;
                        float* xp = X + (size_t)r * DM;
                        float ss = 0.f;
#pragma unroll
                        for (int bj = 0; bj < 2; ++bj)
#pragma unroll
                            for (int n = 0; n < 2; ++n) {
                                const int c = col0 + bj * 128 + n * 16;
                                const f32x4 xn = rv[mm][bj][n] + gv[bj][n] * acc[ai][bj][m][n];
                                *(f32x4*)(xp + c) = xn;
                                if (Hout) {
                                    ss += xn[0] * xn[0] + xn[1] * xn[1] + xn[2] * xn[2] + xn[3] * xn[3];
                                    const f32x4 hv = xn * hg[bj][n];
                                    u32x2 p; p[0] = pk2(hv[0], hv[1]); p[1] = pk2(hv[2], hv[3]);
                                    *(u32x2*)(Hout + (size_t)r * DM + c) = p;
                                }
                            }
                        if (Hout) {
                            ss += __shfl_xor(ss, 16); ss += __shfl_xor(ss, 32);
                            if (fq == 0) atomicAdd(ssq_out + r, ss);
                        }
                    }
                }
#ifdef EPI_ONLY
        } else if (EPI_ONLY == 1) {
#else
        } else if (mode == 1) {
#endif
            const float sc = u.pn < 2 ? 0.125f : 1.0f;
            const f32x4 gbv[2] = {*(const f32x4*)(gate_b + 4 * fq), *(const f32x4*)(gate_b + 16 + 4 * fq)};
            const int ub = u.pm < 64 ? (u.pm >> 3) : 8;
            f32x4 sbv[2][2];
#pragma unroll
            for (int bj = 0; bj < 2; ++bj)
#pragma unroll
                for (int n = 0; n < 2; ++n) sbv[bj][n] = *(const f32x4*)(sbias + (size_t)ub * sb_ld + col0 + bj * 128 + n * 16);
            float rsv[2][4];
#pragma unroll
            for (int ai = 0; ai < 2; ++ai)
#pragma unroll
                for (int m = 0; m < 4; ++m) rsv[ai][m] = rsqrtf(ssq_in[row0 + ai * 128 + m * 16] * (1.0f / 1024.0f) + 1e-6f);
#pragma unroll
            for (int ai = 0; ai < 2; ++ai)
#pragma unroll
                for (int m = 0; m < 4; ++m) {
                    const int r = row0 + ai * 128 + m * 16;
                    const float rs = rsv[ai][m];
                    if (u.pn == 12) {
                        if (wc == 0) {
#pragma unroll
                            for (int n = 0; n < 2; ++n) {
                                const int lc = n * 16 + 4 * fq;
                                *(f32x4*)(G + (size_t)r * 32 + lc) = acc[ai][0][m][n] * rs + sbv[0][n] + gbv[n];
                            }
                        }
                    } else {
                        bf16_t* op = O + (size_t)r * ldo;
#pragma unroll
                        for (int bj = 0; bj < 2; ++bj)
#pragma unroll
                            for (int n = 0; n < 2; ++n) {
                                const f32x4 v = (acc[ai][bj][m][n] * rs + sbv[bj][n]) * sc;
                                u32x2 p; p[0] = pk2(v[0], v[1]); p[1] = pk2(v[2], v[3]);
                                *(u32x2*)(op + col0 + bj * 128 + n * 16) = p;
                            }
                    }
                }
        } else if (mode == 4) {
            const int ub = u.pm < 64 ? (u.pm >> 3) : 8;
            const int ch0 = u.pn * 128 + wc * 32 + 4 * fq;
            const __amdgpu_buffer_rsrc_t ersrc = __builtin_amdgcn_make_buffer_rsrc((void*)EDGE, 0, 288 * 4 * 2 * FFN * 4, 0x00020000);
            LAS float* cst = (LAS float*)(unsigned)(131072 + 1024 + (wr * 4 + wc) * 1280);
            {
                const int ln = fr + 16 * fq, hv = ln >> 5, c = ln & 31;
                const float* cwp = cw + u.pn * 128 + wc * 32; const float* cbp = cb + u.pn * 128 + wc * 32; const float* sbp = sbias + (size_t)ub * sb_ld + u.pn * 256 + wc * 32;
                const float v01 = cwp[hv * 2 * FFN + c];
                const float v23 = cwp[(hv ? FFN : 2 * 2 * FFN) + c];
                const float v45 = cwp[(hv ? 2 * 2 * FFN + FFN : 2 * FFN + FFN) + c];
                const float v67 = cbp[hv * FFN + c];
                const float v89 = sbp[hv * 128 + c];
                cst[ln] = v01; cst[64 + ln] = v23; cst[128 + ln] = v45; cst[192 + ln] = v67; cst[256 + ln] = v89;
            }
            float rsa[2][4];
#pragma unroll
            for (int ai = 0; ai < 2; ++ai)
#pragma unroll
                for (int m = 0; m < 4; ++m) rsa[ai][m] = rsqrtf(ssq_in[row0 + ai * 128 + m * 16] * (1.0f / 1024.0f) + 1e-6f);
#pragma unroll
            for (int n = 0; n < 2; ++n)
#pragma unroll
                for (int jp = 0; jp < 2; ++jp) {
                    __builtin_amdgcn_sched_barrier(0);
                    const int ch = ch0 + 16 * n + 2 * jp;
                    const int lc = 16 * n + 4 * fq + 2 * jp;
                    f32x2 wa[3], wg[3];
#pragma unroll
                    for (int j = 0; j < 3; ++j) { wa[j] = *(const LAS f32x2*)(cst + j * 32 + lc); wg[j] = *(const LAS f32x2*)(cst + (3 + j) * 32 + lc); }
                    const f32x2 ba = *(const LAS f32x2*)(cst + 6 * 32 + lc), bg = *(const LAS f32x2*)(cst + 7 * 32 + lc);
                    const f32x2 sa = *(const LAS f32x2*)(cst + 8 * 32 + lc), sg = *(const LAS f32x2*)(cst + 9 * 32 + lc);
#pragma unroll
                    for (int ai = 0; ai < 2; ++ai) {
                        const int seg = (row0 + ai * 128) >> 6;
                        const unsigned eo0 = fr < 2 ? (unsigned)(((seg * 4 + fr) * 2 * FFN + ch) * 4) : 0xf0000000u, eo3 = fr >= 14 ? (unsigned)(((seg * 4 + fr - 12) * 2 * FFN + ch) * 4) : 0xf0000000u;
                        float y[4][2], e0[4];
#pragma unroll
                        for (int jj = 0; jj < 2; ++jj) {
                            const int j = 2 * jp + jj;
                            float xa[4], xg[4];
#pragma unroll
                            for (int m = 0; m < 4; ++m) { xa[m] = acc[ai][0][m][n][j] * rsa[ai][m] + sa[jj]; xg[m] = acc[ai][1][m][n][j] * rsa[ai][m] + sg[jj]; }
#pragma unroll
                            for (int m = 0; m < 4; ++m) {
                                const int oa = m > 0 ? __builtin_amdgcn_mov_dpp(__builtin_bit_cast(int, xa[m > 0 ? m - 1 : 0]), 0x121, 0xf, 0xf, false) : 0;
                                const int og = m > 0 ? __builtin_amdgcn_mov_dpp(__builtin_bit_cast(int, xg[m > 0 ? m - 1 : 0]), 0x121, 0xf, 0xf, false) : 0;
                                const float pa = __builtin_bit_cast(float, __builtin_amdgcn_update_dpp(oa, __builtin_bit_cast(int, xa[m]), 0x111, 0xf, 0xf, false));
                                const float pg = __builtin_bit_cast(float, __builtin_amdgcn_update_dpp(og, __builtin_bit_cast(int, xg[m]), 0x111, 0xf, 0xf, false));
                                const int qa = m < 3 ? __builtin_amdgcn_mov_dpp(__builtin_bit_cast(int, xa[m < 3 ? m + 1 : 3]), 0x12f, 0xf, 0xf, false) : 0;
                                const int qg = m < 3 ? __builtin_amdgcn_mov_dpp(__builtin_bit_cast(int, xg[m < 3 ? m + 1 : 3]), 0x12f, 0xf, 0xf, false) : 0;
                                const float na = __builtin_bit_cast(float, __builtin_amdgcn_update_dpp(qa, __builtin_bit_cast(int, xa[m]), 0x101, 0xf, 0xf, false));
                                const float ng = __builtin_bit_cast(float, __builtin_amdgcn_update_dpp(qg, __builtin_bit_cast(int, xg[m]), 0x101, 0xf, 0xf, false));
                                const float av = ba[jj] + wa[0][jj] * pa + wa[1][jj] * xa[m] + wa[2][jj] * na;
                                const float gv = bg[jj] + wg[0][jj] * pg + wg[1][jj] * xg[m] + wg[2][jj] * ng;
                                y[m][jj] = av * gv * __builtin_amdgcn_rcpf(1.f + __expf(-gv));
                            }
                            if (jj == 0) { e0[0] = xa[0]; e0[1] = xg[0]; e0[2] = xa[3]; e0[3] = xg[3]; }
                            else {
                                u32x2 v;
                                v[0] = __builtin_bit_cast(unsigned, e0[0]); v[1] = __builtin_bit_cast(unsigned, xa[0]); __builtin_amdgcn_raw_buffer_store_b64(v, ersrc, (int)eo0, 0, 0);
                                v[0] = __builtin_bit_cast(unsigned, e0[1]); v[1] = __builtin_bit_cast(unsigned, xg[0]); __builtin_amdgcn_raw_buffer_store_b64(v, ersrc, (int)(eo0 + FFN * 4), 0, 0);
                                v[0] = __builtin_bit_cast(unsigned, e0[2]); v[1] = __builtin_bit_cast(unsigned, xa[3]); __builtin_amdgcn_raw_buffer_store_b64(v, ersrc, (int)eo3, 0, 0);
                                v[0] = __builtin_bit_cast(unsigned, e0[3]); v[1] = __builtin_bit_cast(unsigned, xg[3]); __builtin_amdgcn_raw_buffer_store_b64(v, ersrc, (int)(eo3 + FFN * 4), 0, 0);
                            }
                        }
#pragma unroll
                        for (int m = 0; m < 4; ++m) {
                            const int r = row0 + ai * 128 + m * 16;
                            *(unsigned*)(ACT + (size_t)r * FFN + ch) = pk2(y[m][0], y[m][1]);
                        }
                    }
                }
        } else if (mode == 3) {
#pragma unroll
            for (int ai = 0; ai < 2; ++ai)
#pragma unroll
                for (int m = 0; m < 4; ++m) {
                    bf16_t* op = O + (size_t)(row0 + ai * 128 + m * 16) * ldo;
#pragma unroll
                    for (int bj = 0; bj < 2; ++bj)
#pragma unroll
                        for (int n = 0; n < 2; ++n) {
                            const f32x4 v = acc[ai][bj][m][n];
                            u32x2 p; p[0] = pk2(v[0], v[1]); p[1] = pk2(v[2], v[3]);
                            *(u32x2*)(op + col0 + bj * 128 + n * 16) = p;
                        }
                }
        } else {
            const bool tile_rope = (u.pn * 256) < ropelim;
            const LAS float* ropeL = (const LAS float*)(unsigned)(131072 + 1024 + 10240);
            const int ub = u.pm < 64 ? (u.pm >> 3) : 8;
            f32x4 sbv[2][2];
#pragma unroll
            for (int bj = 0; bj < 2; ++bj)
#pragma unroll
                for (int n = 0; n < 2; ++n) sbv[bj][n] = *(const f32x4*)(sbias + (size_t)ub * sb_ld + col0 + bj * 128 + n * 16);
            float rsv[2][4];
#pragma unroll
            for (int ai = 0; ai < 2; ++ai)
#pragma unroll
                for (int m = 0; m < 4; ++m) rsv[ai][m] = rsqrtf(ssq_in[row0 + ai * 128 + m * 16] * (1.0f / 1024.0f) + 1e-6f);
#pragma unroll
            for (int ai = 0; ai < 2; ++ai)
#pragma unroll
                for (int m = 0; m < 4; ++m) {
                    const int r = row0 + ai * 128 + m * 16;
                    const float rs = rsv[ai][m];
                    bf16_t* op = O + (size_t)r * ldo;
                    if (tile_rope && r < MLAT) {
                        const int s = r & 2047, pos = (wc & 1) ? (s & 63) : (s >> 6);
                        const f32x4 cs = *(const LAS f32x4*)(ropeL + pos * 16 + 4 * fq), sn = *(const LAS f32x4*)(ropeL + 1024 + pos * 16 + 4 * fq);
#pragma unroll
                        for (int bj = 0; bj < 2; ++bj) {
                            const f32x4 x1 = acc[ai][bj][m][0] * rs + sbv[bj][0], x2 = acc[ai][bj][m][1] * rs + sbv[bj][1];
                            const f32x4 y1 = x1 * cs - x2 * sn, y2 = x2 * cs + x1 * sn;
                            u32x2 p; p[0] = pk2(y1[0], y1[1]); p[1] = pk2(y1[2], y1[3]);
                            *(u32x2*)(op + col0 + bj * 128) = p;
                            p[0] = pk2(y2[0], y2[1]); p[1] = pk2(y2[2], y2[3]);
                            *(u32x2*)(op + col0 + bj * 128 + 16) = p;
                        }
                    } else {
#pragma unroll
                        for (int bj = 0; bj < 2; ++bj)
#pragma unroll
                            for (int n = 0; n < 2; ++n) {
                                const f32x4 v = acc[ai][bj][m][n] * rs + sbv[bj][n];
                                u32x2 p; p[0] = pk2(v[0], v[1]); p[1] = pk2(v[2], v[3]);
                                *(u32x2*)(op + col0 + bj * 128 + n * 16) = p;
                            }
                    }
                }
        }
    }
};

DI void run_gemm(char* shm, const bf16_t* A, const bf16_t* Bt, int M, int N, int K, const Epi& E) {
    pg8::Gemm g; g.A = A; g.Bt = Bt; g.M = M; g.N = N; g.K = K;
    pg8::StaticOrder S; S.init(M, N, (int)gridDim.x, (int)blockIdx.x);
#ifndef NO_GEMM
    pg8::gemm_phase<Epi, pg8::StaticOrder>((LAS unsigned char*)shm, g, S, E);
#endif
    __syncthreads();
}

DI void phase_prologue(const Args& a, char* shm) {
    float* sc = (float*)shm;
    float* red = sc + 9 * 1024;
    const int tid = otid();
    for (int i = tid; i < 9 * 1024; i += 512) { const int r = i >> 10, k = i & 1023; const float v = r < 8 ? a.in[1][r * 1024 + k] : a.in[3][k]; sc[i] = v / (1.f + __expf(-v)); }
    __syncthreads();
    float* mod = (float*)(a.ws + WS_MOD);
    for (int item = blockIdx.x; item < 193; item += gridDim.x) {
        if (item < 192) {
            const int l = item / 48, j0 = (item % 48) * 128, col = tid & 127, kq = tid >> 7;
            const float* W = a.in[lbase(l)] + j0 + col;
            float acc[9];
#pragma unroll
            for (int r = 0; r < 9; ++r) acc[r] = 0.f;
            for (int k = kq * 256; k < kq * 256 + 256; k += 32) {
                float w[32];
#pragma unroll
                for (int j = 0; j < 32; ++j) w[j] = __builtin_nontemporal_load(W + (size_t)(k + j) * 6144);
#pragma unroll
                for (int j = 0; j < 32; j += 4)
#pragma unroll
                    for (int r = 0; r < 9; ++r) { const f32x4 s = *(const f32x4*)(sc + r * 1024 + k + j); acc[r] += s[0] * w[j] + s[1] * w[j + 1] + s[2] * w[j + 2] + s[3] * w[j + 3]; }
            }
#pragma unroll
            for (int r = 0; r < 9; ++r) red[(kq * 9 + r) * 128 + col] = acc[r];
            __syncthreads();
            for (int i = tid; i < 9 * 128; i += 512) {
                const int r = i >> 7, cc = i & 127;
                const float s = red[r * 128 + cc] + red[(9 + r) * 128 + cc] + red[(18 + r) * 128 + cc] + red[(27 + r) * 128 + cc];
                mod[(size_t)(l * 9 + r) * 6144 + j0 + cc] = s + a.in[lbase(l) + 1][j0 + cc];
            }
            __syncthreads();
        } else {
            float* ropec = (float*)(a.ws + WS_ROPE); float* ropes = ropec + 1024; float* lam = ropec + 2048;
            for (int i = tid; i < 1024; i += 512) {
                const int pos = i >> 4, f = i & 15;
                const float inv = powf(10000.0f, -(float)f / 16.0f), ang = (float)pos * inv;
                ropec[i] = cosf(ang); ropes[i] = sinf(ang);
            }
            if (tid < 2) {
                const int l = tid == 0 ? 0 : 3, bs = lbase(l);
                float s1 = 0.f, s2 = 0.f;
                for (int k = 0; k < 64; ++k) { s1 += a.in[bs + 4][k] * a.in[bs + 5][k]; s2 += a.in[bs + 6][k] * a.in[bs + 7][k]; }
                const float lam_init = 0.8f - 0.6f * expf(-0.3f * (float)l);
                lam[tid * 2] = expf(s1) - expf(s2) + lam_init; lam[tid * 2 + 1] = lam_init;
            }
        }
    }
}

DI void convert_st(const float* W, int K, int N, bf16_t* Wt, int kt, int nt4, int upperm, float* T, float* sh, const float* shift, float* sb, int sb_ld) {
    const int tid = otid(), k0 = kt * 64, n0 = nt4 * 256;
    __syncthreads();
#pragma unroll
    for (int it = 0; it < 8; ++it) {
        const int k = it * 8 + (tid >> 6), n4 = (tid & 63) * 4;
        f32x4 v = {0.f, 0.f, 0.f, 0.f};
        if (n0 + n4 < N) v = *(const f32x4*)(W + (size_t)(k0 + k) * N + n0 + n4);
        *(f32x4*)(T + k * 260 + n4) = v;
    }
    if (sb) { for (int i = tid; i < 576; i += 512) sh[i] = shift[(size_t)(i >> 6) * 6144 + k0 + (i & 63)]; }
    __syncthreads();
    const int n = tid >> 1, kh = tid & 1, nn = n0 + n;
    int row = nn;
    if (upperm) { const int f = nn < FFN ? nn : nn - FFN; row = 256 * (f >> 7) + (nn < FFN ? 0 : 128) + (f & 127); }
    float v[32];
#pragma unroll
    for (int i = 0; i < 32; ++i) v[i] = T[(32 * kh + i) * 260 + n];
    bf16_t* dst = Wt + (size_t)row * K + k0 + 32 * kh;
#pragma unroll
    for (int j = 0; j < 4; ++j) {
        u32x4 p; p[0] = pk2(v[8 * j], v[8 * j + 1]); p[1] = pk2(v[8 * j + 2], v[8 * j + 3]); p[2] = pk2(v[8 * j + 4], v[8 * j + 5]); p[3] = pk2(v[8 * j + 6], v[8 * j + 7]);
        *(u32x4*)(dst + 8 * j) = p;
    }
    if (sb) {
#pragma unroll
        for (int rb = 0; rb < 9; ++rb) {
            float p = 0.f;
#pragma unroll
            for (int i = 0; i < 32; i += 4) { const f32x4 s4 = *(const f32x4*)(sh + rb * 64 + 32 * kh + i); p += s4[0] * v[i] + s4[1] * v[i + 1] + s4[2] * v[i + 2] + s4[3] * v[i + 3]; }
            p += __shfl_xor(p, 1);
            if (kh == 0 && nn < N) atomicAdd(sb + (size_t)rb * sb_ld + row, p);
        }
    }
}
DI void phase_convert(const Args& a, char* shm, int l, int which, int idx, int nstride) {
    const int kind = l % 3, bs = lbase(l), nin = nin_of(kind), nint = (nin + 255) >> 8;
    const int n_in = (which & 1) ? nint * 16 : 0, n_out = (which & 2) ? 64 : 0, n_up = (which & 4) ? 22 * 16 : 0, n_down = (which & 8) ? 4 * 44 : 0;
    const int total = n_in + n_out + n_up + n_down;
    unsigned char* wb = a.ws + WS_W;
    float* T = (float*)shm; float* sh = T + 64 * 260;
    const float* mod_l = (const float*)(a.ws + WS_MOD) + (size_t)l * 9 * 6144;
    float* sb_in = (float*)(a.ws + WS_SB) + (size_t)l * SB_LAYER; float* sb_up = sb_in + 9 * SB_IN_LD;
    for (int item = idx; item < total; item += nstride) {
        int it = item;
        if (it < n_in) { convert_st(a.in[bs + 3], 1024, nin, (bf16_t*)(wb + WOFF_IN), it & 15, it >> 4, 0, T, sh, mod_l, sb_in, SB_IN_LD); continue; }
        it -= n_in;
        if (it < n_out) { convert_st(a.in[bs + off_wout(kind)], 1024, 1024, (bf16_t*)(wb + WOFF_OUT), it & 15, it >> 4, 0, T, sh, nullptr, nullptr, 0); continue; }
        it -= n_out;
        if (it < n_up) { convert_st(a.in[bs + off_wout(kind) + 2], 1024, 2 * FFN, (bf16_t*)(wb + WOFF_UP), it & 15, it >> 4, 1, T, sh, mod_l + 3072, sb_up, SB_UP_LD); continue; }
        it -= n_up;
        convert_st(a.in[bs + off_wout(kind) + 5], FFN, 1024, (bf16_t*)(wb + WOFF_DOWN), it % 44, it / 44, 0, T, sh, nullptr, nullptr, 0);
    }
    __syncthreads();
}

DI void phase_prenorm(const float* Xl, const float* Xc, const float* g, const float* mod_l, int scoff, bf16_t* H, float* ssq, int nrows) {
    const int lane = otid() & 63, wid = otid() >> 6, rstride = gridDim.x * 8;
    for (int row0 = blockIdx.x * 8 + wid; row0 < nrows; row0 += 4 * rstride) {
        f32x4 v[4][4];
#pragma unroll
        for (int k = 0; k < 4; ++k) {
            const int rk = row0 + k * rstride, row = rk < nrows ? rk : row0;
            const float* xr = row < MLAT ? Xl + (size_t)row * DM : Xc + (size_t)(row - MLAT) * DM;
#pragma unroll
            for (int i = 0; i < 4; ++i) v[k][i] = *(const f32x4*)(xr + i * 256 + lane * 4);
        }
#pragma unroll
        for (int k = 0; k < 4; ++k) {
            const int row = row0 + k * rstride;
            if (row < nrows) {
                const float* mp = mod_l + (size_t)(row < MLAT ? (row >> 11) : 8) * 6144;
                float ss = 0.f;
#pragma unroll
                for (int i = 0; i < 4; ++i) ss += v[k][i][0] * v[k][i][0] + v[k][i][1] * v[k][i][1] + v[k][i][2] * v[k][i][2] + v[k][i][3] * v[k][i][3];
                ss = wave_sum(ss);
                if (lane == 0) ssq[row] = ss;
#pragma unroll
                for (int i = 0; i < 4; ++i) {
                    const int c = i * 256 + lane * 4;
                    const f32x4 gg = *(const f32x4*)(g + c), sc = *(const f32x4*)(mp + scoff + c);
                    const f32x4 y = (v[k][i] * gg) * (sc + 1.0f);
                    u32x2 p; p[0] = pk2(y[0], y[1]); p[1] = pk2(y[2], y[3]);
                    *(u32x2*)(H + (size_t)row * DM + c) = p;
                }
            }
        }
    }
}
DI void phase_final_norm(const float* X, const float* g, float* out) {
    const int lane = otid() & 63, wid = otid() >> 6, rstride = gridDim.x * 8;
    f32x4 gg[4];
#pragma unroll
    for (int i = 0; i < 4; ++i) gg[i] = *(const f32x4*)(g + i * 256 + lane * 4);
    for (int row0 = blockIdx.x * 8 + wid; row0 < MLAT; row0 += 4 * rstride) {
        f32x4 v[4][4];
#pragma unroll
        for (int k = 0; k < 4; ++k) {
            const int rk = row0 + k * rstride, row = rk < MLAT ? rk : row0;
#pragma unroll
            for (int i = 0; i < 4; ++i) v[k][i] = *(const f32x4*)(X + (size_t)row * DM + i * 256 + lane * 4);
        }
#pragma unroll
        for (int k = 0; k < 4; ++k) {
            const int row = row0 + k * rstride;
            if (row < MLAT) {
                float ss = 0.f;
#pragma unroll
                for (int i = 0; i < 4; ++i) ss += v[k][i][0] * v[k][i][0] + v[k][i][1] * v[k][i][1] + v[k][i][2] * v[k][i][2] + v[k][i][3] * v[k][i][3];
                ss = wave_sum(ss);
                const float rstd = rsqrtf(ss * (1.0f / 1024.0f) + 1e-6f);
#pragma unroll
                for (int i = 0; i < 4; ++i) *(f32x4*)(out + (size_t)row * DM + i * 256 + lane * 4) = v[k][i] * rstd * gg[i];
            }
        }
    }
}

struct AttnP { const bf16_t* QKV; int pitch, qrow, qcol, kcol0, kslot, vcol, ntile, ctxrow0, latrow0, qpos, kpos0; };
constexpr float C2 = 0.125f * 1.4426950408889634f;

template <int NKT, int NDVB, bool SWA>
DI void attn_core(char* shm, const AttnP& P, f32x16 (&O)[NDVB], float& mrow, float& lrow) {
    constexpr int KB = 64 * 144, VS = 64 * NDVB + 32, VB = 64 * VS, STAGE = NKT * KB + VB, NVL = NDVB / 2, CPR = 4 * NDVB  , RPP = 512 / CPR;
    const int tid = otid(), lane = tid & 63, l31 = lane & 31, hh = lane >> 5;
    bf16x8 qf[4];
#pragma unroll
    for (int ks = 0; ks < 4; ++ks) qf[ks] = *(const bf16x8*)(P.QKV + (size_t)(P.qrow + l31) * P.pitch + P.qcol + ks * 16 + hh * 8);
    mrow = -1e30f; lrow = 0.f;
#pragma unroll
    for (int d = 0; d < NDVB; ++d) O[d] = zero16();
    const int kkey = tid >> 3, kch = tid & 7, vkey = tid / CPR, vch = tid % CPR;
    const int vtoff = (4 * hh + ((lane & 15) >> 2)) * VS + ((lane >> 4) & 1) * 32 + (lane & 3) * 8;
    u32x4 kreg[NKT], vreg[NVL];
#define ATT_GLOAD(t) do { const int r0_ = (t) < 4 ? P.ctxrow0 + 64 * (t) : P.latrow0 + 64 * ((t) - 4); \
        _Pragma("unroll") for (int c = 0; c < NKT; ++c) kreg[c] = *(const u32x4*)(P.QKV + (size_t)(r0_ + kkey) * P.pitch + P.kcol0 + c * 64 + kch * 8); \
        _Pragma("unroll") for (int j = 0; j < NVL; ++j) vreg[j] = *(const u32x4*)(P.QKV + (size_t)(r0_ + vkey + RPP * j) * P.pitch + P.vcol + vch * 8); } while (0)
    ATT_GLOAD(0);
    for (int t = 0; t < P.ntile; ++t) {
        char* base = shm + (t & 1) * STAGE;
#pragma unroll
        for (int c = 0; c < NKT; ++c) *(u32x4*)(base + c * KB + kkey * 144 + kch * 16) = kreg[c];
#pragma unroll
        for (int j = 0; j < NVL; ++j) *(u32x4*)(base + NKT * KB + (vkey + RPP * j) * VS + vch * 16) = vreg[j];
        __syncthreads();
        if (t + 1 < P.ntile) ATT_GLOAD(t + 1);
        const char* kbase = base + P.kslot * KB;
        f32x16 S[2]; S[0] = zero16(); S[1] = zero16();
        {
            bf16x8 kf[2][4];
#pragma unroll
            for (int kb = 0; kb < 2; ++kb)
#pragma unroll
                for (int ks = 0; ks < 4; ++ks) kf[kb][ks] = *(const bf16x8*)(kbase + (kb * 32 + l31) * 144 + (ks * 16 + hh * 8) * 2);
            __builtin_amdgcn_sched_barrier(0);
            __builtin_amdgcn_s_setprio(1);
#pragma unroll
            for (int ks = 0; ks < 4; ++ks)
#pragma unroll
                for (int kb = 0; kb < 2; ++kb) S[kb] = mfma32(kf[kb][ks], qf[ks], S[kb]);
            __builtin_amdgcn_s_setprio(0);
        }
        bool need_mask = false;
        if (SWA) { if (t >= 4) { const int k0 = P.kpos0 + 64 * (t - 4); need_mask = (P.qpos + 31 - k0 > 128) || (k0 + 63 - P.qpos > 128); } }
        float mx = -1e30f;
#pragma unroll
        for (int kb = 0; kb < 2; ++kb)
#pragma unroll
            for (int i = 0; i < 16; ++i) {
                if (SWA) { if (need_mask) { const int dd = (P.qpos + l31) - (P.kpos0 + 64 * (t - 4) + kb * 32 + crow(i, hh)); if (dd > 128 || dd < -128) S[kb][i] = -1e30f; } }
                mx = fmaxf(mx, S[kb][i]);
            }
        mx = fmaxf(mx, __shfl_xor(mx, 32));
        const bool grow = mx > mrow + (8.0f / C2);
        const float mnew = grow ? mx : mrow;
        const float mc = mnew * C2;
        float rs = 0.f;
#pragma unroll
        for (int kb = 0; kb < 2; ++kb)
#pragma unroll
            for (int i = 0; i < 16; ++i) { const float p = fexp2(__builtin_fmaf(S[kb][i], C2, -mc)); S[kb][i] = p; rs += p; }
        rs += __shfl_xor(rs, 32);
        if (__any(grow)) {
            const float alpha = fexp2((mrow - mnew) * C2);
            lrow *= alpha;
#pragma unroll
            for (int d = 0; d < NDVB; ++d) O[d] = O[d] * alpha;
        }
        mrow = mnew;
        lrow += rs;
        {
            bf16x8 vf[2][2][NDVB];
#pragma unroll
            for (int kb = 0; kb < 2; ++kb)
#pragma unroll
                for (int s = 0; s < 2; ++s)
#pragma unroll
                    for (int d = 0; d < NDVB; ++d) {
                        const LAS char* vp = (const LAS char*)(LAS char*)(base + NKT * KB) + vtoff + (kb * 32 + s * 16) * VS + d * 64;
                        const s16x4 lo = __builtin_bit_cast(s16x4, __builtin_amdgcn_ds_read_tr16_b64_v4i16((LAS s16x4*)vp));
                        const s16x4 hi = __builtin_bit_cast(s16x4, __builtin_amdgcn_ds_read_tr16_b64_v4i16((LAS s16x4*)(vp + 8 * VS)));
                        vf[kb][s][d] = __builtin_shufflevector(lo, hi, 0, 1, 2, 3, 4, 5, 6, 7);
                    }
            bf16x8 pf[2][2];
#pragma unroll
            for (int kb = 0; kb < 2; ++kb) { pf[kb][0] = pack8(S[kb], 0); pf[kb][1] = pack8(S[kb], 1); }
            __builtin_amdgcn_sched_barrier(0);
            __builtin_amdgcn_s_setprio(1);
#pragma unroll
            for (int kb = 0; kb < 2; ++kb)
#pragma unroll
                for (int s = 0; s < 2; ++s)
#pragma unroll
                    for (int d = 0; d < NDVB; ++d) O[d] = mfma32(vf[kb][s][d], pf[kb][s], O[d]);
            __builtin_amdgcn_s_setprio(0);
        }
    }
#undef ATT_GLOAD
    __syncthreads();
}

DI void phase_da(const Args& a, char* shm, int l, bool need_ctx) {
    const bf16_t* QKV = (const bf16_t*)(a.ws + WS_QKV);
    bf16_t* ATT = (bf16_t*)(a.ws + WS_ATT);
    const float* lamp = (const float*)(a.ws + WS_ROPE) + 2048 + (l == 0 ? 0 : 2);
    const float lam = lamp[0], lam_init = lamp[1];
    const float* subg = a.in[lbase(l) + 8];
    const int lane = otid() & 63, wid = otid() >> 6, l31 = lane & 31, hh = lane >> 5;
    const int comp = wid >> 2, wq = wid & 3;
    float* xch = (float*)shm;
    const int nitem = 1024 + (need_ctx ? 128 : 0);
    for (int item = blockIdx.x; item < nitem; item += gridDim.x) {
        AttnP P; P.QKV = QKV; P.pitch = 3072; P.qpos = 0; P.kpos0 = 0;
        int b, h;
        if (item < 1024) {
            const int xcd = item & 7, j = item >> 3, qb = j & 15, bh = (j >> 4) * 8 + xcd;
            b = bh >> 3; h = bh & 7;
            P.qrow = b * 2048 + qb * 128 + wq * 32; P.ntile = 36;
        } else {
            const int i2 = item - 1024, qb = i2 & 1; h = (i2 >> 1) & 7; b = i2 >> 4;
            P.qrow = MLAT + b * 256 + qb * 128 + wq * 32; P.ntile = 4;
        }
        P.ctxrow0 = MLAT + b * 256; P.latrow0 = b * 2048;
        P.qcol = h * 128 + comp * 64; P.kcol0 = 1024 + h * 128; P.kslot = comp; P.vcol = 2048 + h * 128;
        f32x16 O[4]; float mr, lr;
        attn_core<2, 4, false>(shm, P, O, mr, lr);
        if (comp == 1) {
            const float inv1 = lam / lr;
#pragma unroll
            for (int d = 0; d < 4; ++d)
#pragma unroll
                for (int i = 0; i < 16; ++i) xch[((wq * 4 + d) * 16 + i) * 64 + lane] = O[d][i] * inv1;
        }
        __syncthreads();
        if (comp == 0) {
            const float inv0 = 1.0f / lr;
            float ss = 0.f;
#pragma unroll
            for (int d = 0; d < 4; ++d)
#pragma unroll
                for (int i = 0; i < 16; ++i) { const float o = O[d][i] * inv0 - xch[((wq * 4 + d) * 16 + i) * 64 + lane]; O[d][i] = o; ss += o * o; }
            ss += __shfl_xor(ss, 32);
            const float rstd = rsqrtf(ss * (1.0f / 128.0f) + 1e-6f) * (1.0f - lam_init);
            bf16_t* op = ATT + (size_t)(P.qrow + l31) * DM + h * 128;
#pragma unroll
            for (int d = 0; d < 4; ++d)
#pragma unroll
                for (int ig = 0; ig < 4; ++ig) {
                    const int dv = 32 * d + 8 * ig + 4 * hh;
                    const f32x4 g4 = *(const f32x4*)(subg + dv);
                    u32x2 p; p[0] = pk2(O[d][4 * ig] * rstd * g4[0], O[d][4 * ig + 1] * rstd * g4[1]);
                    p[1] = pk2(O[d][4 * ig + 2] * rstd * g4[2], O[d][4 * ig + 3] * rstd * g4[3]);
                    *(u32x2*)(op + dv) = p;
                }
        }
        __syncthreads();
    }
}

DI void phase_swa(const Args& a, char* shm, int l, bool need_ctx) {
    const bf16_t* QKV = (const bf16_t*)(a.ws + WS_QKV);
    bf16_t* ATT = (bf16_t*)(a.ws + WS_ATT);
    const float* sink = a.in[lbase(l) + 4];
    const int lane = otid() & 63, wid = otid() >> 6, l31 = lane & 31, hh = lane >> 5;
    const int nitem = 1024 + (need_ctx ? 128 : 0);
    for (int item = blockIdx.x; item < nitem; item += gridDim.x) {
        AttnP P; P.QKV = QKV; P.pitch = 1536; P.kslot = 0;
        int b, kvh;
        if (item < 1024) {
            const int xcd = item & 7, j_ = item >> 3, qb = j_ & 31, grp = (j_ >> 5) * 8 + xcd;
            kvh = grp & 3; b = grp >> 2;
            const int q0 = qb * 64, ks = q0 - 128 < 0 ? 0 : q0 - 128, ke = q0 + 192 > 2048 ? 2048 : q0 + 192;
            P.ntile = 4 + ((ke - ks) >> 6); P.latrow0 = b * 2048 + ks; P.kpos0 = ks;
            P.qpos = q0 + (wid & 1) * 32; P.qrow = b * 2048 + P.qpos;
        } else {
            const int i2 = item - 1024, j = i2 & 3; kvh = (i2 >> 2) & 3; b = i2 >> 4;
            P.ntile = 4; P.latrow0 = 0; P.kpos0 = 0; P.qpos = 0;
            P.qrow = MLAT + b * 256 + j * 64 + (wid & 1) * 32;
        }
        const int head = kvh * 4 + (wid >> 1);
        P.ctxrow0 = MLAT + b * 256;
        P.qcol = head * 64; P.kcol0 = 1024 + kvh * 64; P.vcol = 1280 + kvh * 64;
        f32x16 O[2]; float mr, lr;
        attn_core<1, 2, true>(shm, P, O, mr, lr);
        const float ltot = lr + fexp2(sink[head] * 1.4426950408889634f - mr * C2);
        const float inv = 1.0f / ltot;
        bf16_t* op = ATT + (size_t)(P.qrow + l31) * DM + head * 64;
#pragma unroll
        for (int d = 0; d < 2; ++d)
#pragma unroll
            for (int ig = 0; ig < 4; ++ig) {
                const int dv = 32 * d + 8 * ig + 4 * hh;
                u32x2 p; p[0] = pk2(O[d][4 * ig] * inv, O[d][4 * ig + 1] * inv); p[1] = pk2(O[d][4 * ig + 2] * inv, O[d][4 * ig + 3] * inv);
                *(u32x2*)(op + dv) = p;
            }
    }
}

DI int ml_row(int b, int dir, int p) { return p < 256 ? MLAT + b * 256 + (dir ? 255 - p : p) : b * 2048 + (dir ? 2047 - (p - 256) : (p - 256)); }

DI void phase_mlstm(const Args& a, char* shm) {
    const bf16_t* QKV = (const bf16_t*)(a.ws + WS_QKV);
    const float* G = (const float*)(a.ws + WS_G);
    constexpr int pitch = 3328;
    float* sA = (float*)shm; float* sB = sA + 2304; float* sM = sB + 2304; float* sN = sM + 2304;
    char* Qs = shm + 32768; char* Ks = Qs + 9216; char* KgT = Ks + 9216; char* Vt = KgT + 9216; char* Cs = Vt + 18432;
    const int tid = otid(), lane = tid & 63, wid = tid >> 6, l31 = lane & 31, hh = lane >> 5;
    const int eb = wid >> 1, tb = wid & 1;
    for (int item = blockIdx.x; item < 128; item += gridDim.x) {
        const int b = item >> 4, h = (item >> 1) & 7, dir = item & 1;
        bf16_t* HD = (bf16_t*)(a.ws + (dir ? WS_HB : WS_HF));
        __syncthreads();
        for (int p = tid; p < 2304; p += 512) {
            const int row = ml_row(b, dir, p);
            const float ig = G[(size_t)row * 32 + (2 * dir) * 8 + h], fg = G[(size_t)row * 32 + (2 * dir + 1) * 8 + h];
            sA[p] = ig; sB[p] = fminf(fg, 0.f) - log1pf(expf(-fabsf(fg)));
        }
        for (int i = tid; i < 128 * 72 / 2; i += 512) ((unsigned*)Cs)[i] = 0u;
        if (tid < 64) sN[tid] = 0.f;
        __syncthreads();
        if (wid == 0) {
            const int p0 = lane * 36;
            float s = 0.f;
            for (int i = 0; i < 36; ++i) s += sB[p0 + i];
            float incl = s;
#pragma unroll
            for (int d = 1; d < 64; d <<= 1) { const float t = __shfl_up(incl, d); if (lane >= d) incl += t; }
            float run = incl - s, mxl = -3.0e38f;
            for (int i = 0; i < 36; ++i) { run += sB[p0 + i]; const float aa = sA[p0 + i] - run; sA[p0 + i] = aa; sM[p0 + i] = run; mxl = fmaxf(mxl, aa); }
            float inclm = mxl;
#pragma unroll
            for (int d = 1; d < 64; d <<= 1) { const float t = __shfl_up(inclm, d); if (lane >= d) inclm = fmaxf(inclm, t); }
            float offm = __shfl_up(inclm, 1); if (lane == 0) offm = 0.f;
            float runm = fmaxf(offm, 0.f);
            for (int i = 0; i < 36; ++i) { runm = fmaxf(runm, sA[p0 + i]); sB[p0 + i] = runm; sM[p0 + i] += runm; }
        }
        f32x16 Cacc = zero16(); float nacc = 0.f;
        const int qs_ = tid >> 3, qch = tid & 7, ss_ = tid & 63, sch = tid >> 6;
        const int spos = (ss_ & ~12) | ((ss_ & 4) << 1) | ((ss_ & 8) >> 1);
        u32x4 qreg, kreg, vreg[2];
#define ML_GLOAD(c) do { const int rq_ = ml_row(b, dir, 64 * (c) + qs_), rs_ = ml_row(b, dir, 64 * (c) + ss_); \
        qreg = *(const u32x4*)(QKV + (size_t)rq_ * pitch + h * 64 + qch * 8); \
        kreg = *(const u32x4*)(QKV + (size_t)rs_ * pitch + 512 + h * 64 + sch * 8); \
        vreg[0] = *(const u32x4*)(QKV + (size_t)rs_ * pitch + 1024 + h * 128 + sch * 8); \
        vreg[1] = *(const u32x4*)(QKV + (size_t)rs_ * pitch + 1024 + h * 128 + (sch + 8) * 8); } while (0)
        ML_GLOAD(0);
        __syncthreads();
        for (int c = 0; c < 36; ++c) {
            const int p0 = 64 * c;
            const float Aprev = c ? sB[p0 - 1] : 0.f, Aend = sB[p0 + 63], decay = __expf(Aprev - Aend);
            *(u32x4*)(Qs + qs_ * 144 + qch * 16) = qreg;
            *(u32x4*)(Ks + ss_ * 144 + sch * 16) = kreg;
            {
                const float gs = __expf(sA[p0 + ss_] - Aend);
#pragma unroll
                for (int i = 0; i < 8; ++i) {
                    const unsigned w = kreg[i >> 1];
                    const float kv = (i & 1) ? bfhi(w) : bflo(w);
                    *(unsigned short*)(KgT + (sch * 8 + i) * 144 + spos * 2) = (unsigned short)(pk2(kv * gs, 0.f) & 0xffffu);
                }
#pragma unroll
                for (int j = 0; j < 2; ++j)
#pragma unroll
                    for (int i = 0; i < 8; ++i)
                        *(unsigned short*)(Vt + ((sch + 8 * j) * 8 + i) * 144 + spos * 2) = (unsigned short)((vreg[j][i >> 1] >> (16 * (i & 1))) & 0xffffu);
            }
            __syncthreads();
            if (c + 1 < 36) ML_GLOAD(c + 1);
            const int t = 32 * tb + l31;
            const float At = sB[p0 + t], inter = __expf(Aprev - At);
            bf16x8 qf[4];
#pragma unroll
            for (int ks = 0; ks < 4; ++ks) qf[ks] = *(const bf16x8*)(Qs + t * 144 + (ks * 16 + hh * 8) * 2);
            f32x16 S[2]; S[0] = zero16(); S[1] = zero16();
#pragma unroll
            for (int sb = 0; sb < 2; ++sb)
                if (sb <= tb) {
#pragma unroll
                    for (int ks = 0; ks < 4; ++ks) { const bf16x8 af = *(const bf16x8*)(Ks + (sb * 32 + l31) * 144 + (ks * 16 + hh * 8) * 2); S[sb] = mfma32(af, qf[ks], S[sb]); }
                }
            float colsum = 0.f;
#pragma unroll
            for (int sb = 0; sb < 2; ++sb)
                if (sb <= tb) {
#pragma unroll
                    for (int iq = 0; iq < 4; ++iq) {
                        const int s0 = 32 * sb + 8 * iq + 4 * hh;
                        const f32x4 a4 = *(const f32x4*)(sA + p0 + s0);
#pragma unroll
                        for (int j = 0; j < 4; ++j) {
                            const float w = (s0 + j <= t) ? __expf(a4[j] - At) : 0.f;
                            const float pv = S[sb][4 * iq + j] * w; S[sb][4 * iq + j] = pv; colsum += pv;
                        }
                    }
                }
            colsum += __shfl_xor(colsum, 32);
            float qn = 0.f;
#pragma unroll
            for (int j = 0; j < 4; ++j) {
                const u32x4 q8 = *(const u32x4*)(Qs + t * 144 + (32 * hh + 8 * j) * 2);
                const f32x4 n0 = *(const f32x4*)(sN + 32 * hh + 8 * j), n1 = *(const f32x4*)(sN + 32 * hh + 8 * j + 4);
                qn += bflo(q8[0]) * n0[0] + bfhi(q8[0]) * n0[1] + bflo(q8[1]) * n0[2] + bfhi(q8[1]) * n0[3] + bflo(q8[2]) * n1[0] + bfhi(q8[2]) * n1[1] + bflo(q8[3]) * n1[2] + bfhi(q8[3]) * n1[3];
            }
            qn += __shfl_xor(qn, 32);
            const float den = inter * qn + colsum, mt = sM[p0 + t];
            const float rinv = 1.0f / fmaxf(fabsf(den), __expf(-mt));
            bf16x8 vf[4];
#pragma unroll
            for (int ks = 0; ks < 4; ++ks) vf[ks] = *(const bf16x8*)(Vt + (32 * eb + l31) * 144 + (ks * 16 + hh * 8) * 2);
            f32x16 acc1 = zero16(), acc2 = zero16();
#pragma unroll
            for (int ks = 0; ks < 4; ++ks) { const bf16x8 cf = *(const bf16x8*)(Cs + (32 * eb + l31) * 144 + (ks * 16 + hh * 8) * 2); acc1 = mfma32(cf, qf[ks], acc1); }
#pragma unroll
            for (int sb = 0; sb < 2; ++sb)
                if (sb <= tb) {
#pragma unroll
                    for (int s = 0; s < 2; ++s) acc2 = mfma32(vf[2 * sb + s], pack8(S[sb], s), acc2);
                }
            {
                bf16_t* op = HD + (size_t)ml_row(b, dir, p0 + t) * DM + h * 128 + 32 * eb;
#pragma unroll
                for (int ig = 0; ig < 4; ++ig) {
                    u32x2 p; p[0] = pk2((acc1[4 * ig] * inter + acc2[4 * ig]) * rinv, (acc1[4 * ig + 1] * inter + acc2[4 * ig + 1]) * rinv);
                    p[1] = pk2((acc1[4 * ig + 2] * inter + acc2[4 * ig + 2]) * rinv, (acc1[4 * ig + 3] * inter + acc2[4 * ig + 3]) * rinv);
                    *(u32x2*)(op + 8 * ig + 4 * hh) = p;
                }
            }
            Cacc = Cacc * decay;
#pragma unroll
            for (int ks = 0; ks < 4; ++ks) { const bf16x8 kg = *(const bf16x8*)(KgT + (32 * tb + l31) * 144 + (ks * 16 + hh * 8) * 2); Cacc = mfma32(vf[ks], kg, Cacc); }
            if (wid == 0) {
                float sum = 0.f;
#pragma unroll
                for (int j = 0; j < 8; ++j) { const u32x4 k8 = *(const u32x4*)(KgT + lane * 144 + j * 16); sum += bflo(k8[0]) + bfhi(k8[0]) + bflo(k8[1]) + bfhi(k8[1]) + bflo(k8[2]) + bfhi(k8[2]) + bflo(k8[3]) + bfhi(k8[3]); }
                nacc = nacc * decay + sum;
            }
            __syncthreads();
#pragma unroll
            for (int i = 0; i < 16; ++i) *(unsigned short*)(Cs + (32 * eb + crow(i, hh)) * 144 + (32 * tb + l31) * 2) = (unsigned short)(pk2(Cacc[i], 0.f) & 0xffffu);
            if (wid == 0) sN[lane] = nacc;
        }
#undef ML_GLOAD
    }
    __syncthreads();
}

DI void phase_ml_finish(const Args& a, int l, int nrows) {
    const bf16_t* HF = (const bf16_t*)(a.ws + WS_HF); const bf16_t* HB = (const bf16_t*)(a.ws + WS_HB);
    const bf16_t* QKV = (const bf16_t*)(a.ws + WS_QKV);
    bf16_t* ATT = (bf16_t*)(a.ws + WS_ATT);
    const float* ng = a.in[lbase(l) + 5];
    const int lane = otid() & 63, wid = otid() >> 6, rstride = gridDim.x * 8, c0 = lane * 16;
    f32x4 gq[4];
#pragma unroll
    for (int q = 0; q < 4; ++q) gq[q] = *(const f32x4*)(ng + c0 + 4 * q);
    for (int row0 = blockIdx.x * 8 + wid; row0 < nrows; row0 += 3 * rstride) {
        u32x4 f[3][2], bk[3][2], o8[3][2];
#pragma unroll
        for (int k = 0; k < 3; ++k) {
            const int rk = row0 + k * rstride, row = rk < nrows ? rk : row0;
#pragma unroll
            for (int j = 0; j < 2; ++j) {
                f[k][j] = *(const u32x4*)(HF + (size_t)row * DM + c0 + 8 * j); bk[k][j] = *(const u32x4*)(HB + (size_t)row * DM + c0 + 8 * j);
                o8[k][j] = *(const u32x4*)(QKV + (size_t)row * 3328 + 2048 + c0 + 8 * j);
            }
        }
#pragma unroll
        for (int k = 0; k < 3; ++k) {
            const int row = row0 + k * rstride;
            if (row < nrows) {
                float v[16]; float ss = 0.f;
#pragma unroll
                for (int j = 0; j < 2; ++j)
#pragma unroll
                    for (int i = 0; i < 4; ++i) { v[8 * j + 2 * i] = bflo(f[k][j][i]) + bflo(bk[k][j][i]); v[8 * j + 2 * i + 1] = bfhi(f[k][j][i]) + bfhi(bk[k][j][i]); }
#pragma unroll
                for (int i = 0; i < 16; ++i) ss += v[i] * v[i];
                ss += __shfl_xor(ss, 1); ss += __shfl_xor(ss, 2); ss += __shfl_xor(ss, 4);
                const float rstd = rsqrtf(ss * (1.0f / 128.0f) + 1e-6f);
#pragma unroll
                for (int j = 0; j < 2; ++j) {
                    float y[8];
#pragma unroll
                    for (int i = 0; i < 4; ++i) {
                        const float oa = bflo(o8[k][j][i]), ob = bfhi(o8[k][j][i]);
                        const f32x4 gg = gq[2 * j + (i >> 1)];
                        const float ga = gg[2 * (i & 1)], gb = gg[2 * (i & 1) + 1];
                        y[2 * i] = v[8 * j + 2 * i] * rstd * ga / (1.f + __expf(-oa));
                        y[2 * i + 1] = v[8 * j + 2 * i + 1] * rstd * gb / (1.f + __expf(-ob));
                    }
                    u32x4 p; p[0] = pk2(y[0], y[1]); p[1] = pk2(y[2], y[3]); p[2] = pk2(y[4], y[5]); p[3] = pk2(y[6], y[7]);
                    *(u32x4*)(ATT + (size_t)row * DM + c0 + 8 * j) = p;
                }
            }
        }
    }
}

DI void phase_conv(const Args& a, int l, int half, int nrows) {
    const bf16_t* U = (const bf16_t*)(a.ws + WS_U);
    bf16_t* ACT = (bf16_t*)(a.ws + WS_ACT);
    const int kind = l % 3, bs = lbase(l);
    const float* cw = a.in[bs + off_wout(kind) + 3]; const float* cb = a.in[bs + off_wout(kind) + 4];
    const float* ssq = (const float*)(a.ws + WS_SSQ) + (size_t)(2 * l + 1) * MROWS;
    const float* sb_up = (const float*)(a.ws + WS_SB) + (size_t)l * SB_LAYER + 9 * SB_IN_LD + (half ? UP_T0 * 256 : 0);
    const int upitch = half ? (22 - UP_T0) * 256 : UP_T0 * 256, cpr = upitch >> 3, c0 = half ? UP_T0 * 128 : 0;
    const int nunits = (nrows >> 3) * cpr;
    for (int u = blockIdx.x * 512 + otid(); u < nunits; u += gridDim.x * 512) {
        const int strip = u / cpr, chunk = u - strip * cpr, r0 = strip * 8;
        const int fa = c0 + chunk * 4, uca = 256 * (chunk >> 5) + 4 * (chunk & 31);
        const int ub = r0 < MLAT ? (r0 >> 11) : 8;
        f32x4 wa[3], wg[3];
#pragma unroll
        for (int j = 0; j < 3; ++j) { wa[j] = *(const f32x4*)(cw + (size_t)j * 2 * FFN + fa); wg[j] = *(const f32x4*)(cw + (size_t)j * 2 * FFN + FFN + fa); }
        const f32x4 ba = *(const f32x4*)(cb + fa), bg = *(const f32x4*)(cb + FFN + fa);
        const f32x4 sa = *(const f32x4*)(sb_up + (size_t)ub * SB_UP_LD + uca), sg = *(const f32x4*)(sb_up + (size_t)ub * SB_UP_LD + uca + 128);
        const bool has_prev = r0 < MLAT ? (r0 & 2047) != 0 : ((r0 - MLAT) & 255) != 0;
        const int rn = r0 + 8;
        const bool has_next = rn < MLAT ? (rn & 2047) != 0 : (rn < MROWS && ((rn - MLAT) & 255) != 0);
        const bf16_t* up = U + (size_t)r0 * upitch + uca;
        u32x2 ua[10], ug[10]; float rsv[10];
#pragma unroll
        for (int i = 0; i < 10; ++i) {
            int ro = i - 1; if (i == 0 && !has_prev) ro = 0; if (i == 9 && !has_next) ro = 7;
            const bf16_t* rp = up + (ptrdiff_t)ro * upitch;
            ua[i] = *(const u32x2*)(rp); ug[i] = *(const u32x2*)(rp + 128); rsv[i] = ssq[r0 + ro];
        }
        f32x4 xa[10], xg[10];
#pragma unroll
        for (int i = 0; i < 10; ++i) {
            const float rs_ = rsqrtf(rsv[i] * (1.0f / 1024.0f) + 1e-6f);
            xa[i] = (f32x4){bflo(ua[i][0]), bfhi(ua[i][0]), bflo(ua[i][1]), bfhi(ua[i][1])} * rs_ + sa;
            xg[i] = (f32x4){bflo(ug[i][0]), bfhi(ug[i][0]), bflo(ug[i][1]), bfhi(ug[i][1])} * rs_ + sg;
        }
        const float fp = has_prev ? 1.f : 0.f, fn = has_next ? 1.f : 0.f;
        xa[0] = xa[0] * fp; xg[0] = xg[0] * fp; xa[9] = xa[9] * fn; xg[9] = xg[9] * fn;
#pragma unroll
        for (int i = 0; i < 8; ++i) {
            const f32x4 av = ba + wa[0] * xa[i] + wa[1] * xa[i + 1] + wa[2] * xa[i + 2];
            const f32x4 gv = bg + wg[0] * xg[i] + wg[1] * xg[i + 1] + wg[2] * xg[i + 2];
            float y[4];
#pragma unroll
            for (int q = 0; q < 4; ++q) y[q] = av[q] * gv[q] / (1.f + __expf(-gv[q]));
            u32x2 p; p[0] = pk2(y[0], y[1]); p[1] = pk2(y[2], y[3]);
            *(u32x2*)(ACT + (size_t)(r0 + i) * FFN + fa) = p;
        }
    }
}

DI void phase_conv_fix(const Args& a, int l, int nrows) {
    const float* EDGE = (const float*)(a.ws + WS_U);
    bf16_t* ACT = (bf16_t*)(a.ws + WS_ACT);
    const int kind = l % 3, bs = lbase(l);
    const float* cw = a.in[bs + off_wout(kind) + 3]; const float* cb = a.in[bs + off_wout(kind) + 4];
    const int nb = (nrows >> 6) - 1, total = nb * 704;
    for (int u = blockIdx.x * 512 + otid(); u < total; u += gridDim.x * 512) {
        const int bb = u / 704, ch = (u - bb * 704) * 4, r = 64 * (bb + 1);
        const bool interior = r < MLAT ? (r & 2047) != 0 : ((r - MLAT) & 255) != 0;
        if (!interior) continue;
        const float* eA = EDGE + ((size_t)(bb * 4 + 2) * 2) * FFN + ch;
        const float* eB = eA + 2 * FFN;
        const float* eC = EDGE + ((size_t)((bb + 1) * 4) * 2) * FFN + ch;
        const float* eD = eC + 2 * FFN;
        f32x4 wa[3], wg[3];
#pragma unroll
        for (int j = 0; j < 3; ++j) { wa[j] = *(const f32x4*)(cw + (size_t)j * 2 * FFN + ch); wg[j] = *(const f32x4*)(cw + (size_t)j * 2 * FFN + FFN + ch); }
        const f32x4 ba = *(const f32x4*)(cb + ch), bg = *(const f32x4*)(cb + FFN + ch);
        const f32x4 aA = *(const f32x4*)(eA), gA = *(const f32x4*)(eA + FFN), aB = *(const f32x4*)(eB), gB = *(const f32x4*)(eB + FFN);
        const f32x4 aC = *(const f32x4*)(eC), gC = *(const f32x4*)(eC + FFN), aD = *(const f32x4*)(eD), gD = *(const f32x4*)(eD + FFN);
        const f32x4 a1 = ba + wa[0] * aA + wa[1] * aB + wa[2] * aC, g1 = bg + wg[0] * gA + wg[1] * gB + wg[2] * gC;
        const f32x4 a2 = ba + wa[0] * aB + wa[1] * aC + wa[2] * aD, g2 = bg + wg[0] * gB + wg[1] * gC + wg[2] * gD;
        float y[4], z[4];
#pragma unroll
        for (int q = 0; q < 4; ++q) { y[q] = a1[q] * g1[q] / (1.f + __expf(-g1[q])); z[q] = a2[q] * g2[q] / (1.f + __expf(-g2[q])); }
        u32x2 p; p[0] = pk2(y[0], y[1]); p[1] = pk2(y[2], y[3]);
        *(u32x2*)(ACT + (size_t)(r - 1) * FFN + ch) = p;
        p[0] = pk2(z[0], z[1]); p[1] = pk2(z[2], z[3]);
        *(u32x2*)(ACT + (size_t)r * FFN + ch) = p;
    }
}

#define XB_TMO      128
#define XB_XCNT(j)  (256  + 64 * (j))
#define XB_XSUB(j)  (1280 + 64 * (j))
#define XB_XGEN(j)  (2304 + 64 * (j))
#define XB_TOP      3328
#define XB_TOPGEN   3392
#define XCD_BAR_WORDS 3456
#define XB_SPIN_CAP (1u << 18)

__device__ __forceinline__ unsigned xb_ld(unsigned* p)              { return __hip_atomic_load(p, __ATOMIC_RELAXED, __HIP_MEMORY_SCOPE_AGENT); }
__device__ __forceinline__ unsigned xb_add(unsigned* p, unsigned v) { return __hip_atomic_fetch_add(p, v, __ATOMIC_RELAXED, __HIP_MEMORY_SCOPE_AGENT); }
__device__ __forceinline__ unsigned xb_xcc_id() { return (unsigned)__builtin_amdgcn_s_getreg((3 << 11) | 20) & 0xFu; }
#define XB_SPIN(cond, bar) do { unsigned _sp = 0; while (cond) { __builtin_amdgcn_s_sleep(1); \
    if ((++_sp & 255u) == 0u) { if (xb_ld(&(bar)[XB_TMO])) break; if (_sp > XB_SPIN_CAP) { atomicAdd(&(bar)[XB_TMO], 1u); break; } } } } while (0)

struct XcdBarrier {
    unsigned* bar; unsigned x;
    volatile LAS unsigned* st;
};

__device__ __forceinline__ XcdBarrier xcd_barrier_post(unsigned* bar, volatile LAS unsigned* st) {
    XcdBarrier b; b.bar = bar; b.x = xb_xcc_id(); b.st = st;
    if (otid() == 0) (void)xb_add(&bar[XB_XCNT(b.x)], 1u);
    return b;
}
__device__ __forceinline__ void xcd_barrier_complete(unsigned* bar, unsigned x, unsigned& nloc, unsigned& nx) {
    const unsigned G = gridDim.x * gridDim.y * gridDim.z;
    unsigned sum, cnt, mine, sp = 0u;
    for (;;) {
        sum = 0u; cnt = 0u; mine = 0u;
#pragma unroll
        for (unsigned j = 0; j < 16; ++j) { const unsigned c = xb_ld(&bar[XB_XCNT(j)]); sum += c; cnt += (c > 0u) ? 1u : 0u; mine = (j == x) ? c : mine; }
        if (sum == G) break;
        __builtin_amdgcn_s_sleep(1);
        if ((++sp & 255u) == 0u) { if (xb_ld(&bar[XB_TMO])) break; if (sp > XB_SPIN_CAP) { atomicAdd(&bar[XB_TMO], 1u); break; } }
    }
    nloc = mine > 0u ? mine : 1u; nx = cnt > 0u ? cnt : 1u;
}

__device__ __forceinline__ void xcd_barrier(const XcdBarrier& b) {
    asm volatile("s_waitcnt vmcnt(0)" ::: "memory");
    __syncthreads();
    if (otid() == 0) {
        unsigned* bar = b.bar;
        __builtin_amdgcn_s_waitcnt(0);
        unsigned nloc = b.st[0], nx = b.st[1];
        if (nloc == 0u) { xcd_barrier_complete(bar, b.x, nloc, nx); b.st[0] = nloc; b.st[1] = nx; }
        const unsigned old = xb_add(&bar[XB_XSUB(b.x)], 1u);
        const unsigned gen = old / nloc;
        if (old + 1u == (gen + 1u) * nloc) {
            __builtin_amdgcn_fence(__ATOMIC_RELEASE, "agent");
            asm volatile("s_waitcnt vmcnt(0)" ::: "memory");
            const unsigned og = xb_add(&bar[XB_TOP], 1u);
            const unsigned tg = og / nx;
            if (og + 1u == (tg + 1u) * nx) xb_add(&bar[XB_TOPGEN], 1u);
            else XB_SPIN(xb_ld(&bar[XB_TOPGEN]) == tg, bar);
            __builtin_amdgcn_fence(__ATOMIC_ACQUIRE, "agent");
            xb_add(&bar[XB_XGEN(b.x)], 1u);
            asm volatile("s_waitcnt vmcnt(0)" ::: "memory");
        } else {
            XB_SPIN(xb_ld(&bar[XB_XGEN(b.x)]) == gen, bar);
            __builtin_amdgcn_fence(__ATOMIC_ACQUIRE, "agent");
            asm volatile("s_waitcnt vmcnt(0)" ::: "memory");
        }
    }
    __syncthreads();
}

__host__ __device__ inline bool phase_active(int ph) {
    if (ph == 0 || ph == 45) return true;
    const int l = (ph - 1) / 11, s = (ph - 1) % 11;
    if (s == 3) return (l % 3) == 1;
    if (s == 5 || s == 8 || s == 9) return false;
    if (s == 0) return l == 0;
    return true;
}

DI void run_phase(const Args& a, char* shm, int ph) {
    if (ph == 0) { phase_prologue(a, shm); return; }
    float* X = (float*)(a.ws + WS_X);
    if (ph == 45) { phase_final_norm(X, a.in[57], a.out); return; }
    const int l = (ph - 1) / 11, s = (ph - 1) % 11, kind = l % 3, bs = lbase(l);
    const bool need_ctx = l < 3;
    const int Mff = need_ctx ? MROWS : MLAT;
    const float* mod_l = (const float*)(a.ws + WS_MOD) + (size_t)l * 9 * 6144;
    const float* Xl = l == 0 ? a.in[0] : X; const float* Xc = l == 0 ? a.in[2] : X + (size_t)MLAT * DM;
    bf16_t* H = (bf16_t*)(a.ws + WS_H);
    unsigned char* wb = a.ws + WS_W;
    float* ssq1 = (float*)(a.ws + WS_SSQ) + (size_t)(2 * l) * MROWS; float* ssq2 = ssq1 + MROWS;
    const float* sb_in = (const float*)(a.ws + WS_SB) + (size_t)l * SB_LAYER; const float* sb_up = sb_in + 9 * SB_IN_LD;
    if (s == 1 || s == 4 || s == 6 || s == 8 || s == 10) {
        Epi E; E.mode = 0; E.O = nullptr; E.ldo = 0; E.ropelim = 0; E.ropec = (const float*)(a.ws + WS_ROPE); E.ropes = E.ropec + 1024;
        E.G = (float*)(a.ws + WS_G); E.gate_b = nullptr; E.X = X; E.res_lat = nullptr; E.res_ctx = nullptr; E.gate = nullptr;
        E.ssq_in = nullptr; E.sbias = nullptr; E.sb_ld = 0; E.Hout = nullptr; E.hgain = (const float*)(a.ws + WS_HG); E.ssq_out = nullptr;
        E.cw = nullptr; E.cb = nullptr; E.ACT = nullptr; E.EDGE = nullptr;
        const bf16_t* A = H; const bf16_t* Bt = (const bf16_t*)(wb + WOFF_IN); int M = MROWS, N = 1024, K = 1024;
        if (s == 1) {
            E.O = (bf16_t*)(a.ws + WS_QKV); E.ldo = ninpad_of(kind); N = ninpad_of(kind);
            E.ssq_in = ssq1; E.sbias = sb_in; E.sb_ld = SB_IN_LD;
            if (kind == 0) { E.ropelim = 2048; } else if (kind == 1) { E.mode = 1; E.gate_b = a.in[bs + 4]; } else { E.ropelim = 1280; }
        } else if (s == 4) {
            E.mode = 2; E.res_lat = Xl; E.res_ctx = Xc; E.gate = mod_l + 2048;
            E.Hout = H; E.hgain = (const float*)(a.ws + WS_HG) + (size_t)((4 + l) * 9) * 1024; E.ssq_out = ssq2;
            A = (const bf16_t*)(a.ws + WS_ATT); Bt = (const bf16_t*)(wb + WOFF_OUT); M = Mff;
        } else if (s == 10) {
            E.mode = 2; E.res_lat = X; E.res_ctx = X + (size_t)MLAT * DM; E.gate = mod_l + 5120;
            if (l < 3) { E.Hout = H; E.hgain = (const float*)(a.ws + WS_HG) + (size_t)((l + 1) * 9) * 1024; E.ssq_out = ssq1 + 2 * MROWS; }
            A = (const bf16_t*)(a.ws + WS_ACT); Bt = (const bf16_t*)(wb + WOFF_DOWN); M = Mff; K = FFN;
        } else {
            E.mode = 4; N = 2 * FFN; M = Mff;
            E.ssq_in = ssq2; E.sbias = sb_up; E.sb_ld = SB_UP_LD;
            E.cw = a.in[bs + off_wout(kind) + 3]; E.cb = a.in[bs + off_wout(kind) + 4]; E.ACT = (bf16_t*)(a.ws + WS_ACT); E.EDGE = (float*)(a.ws + WS_U);
            Bt = (const bf16_t*)(wb + WOFF_UP);
        }
        if (s == 1 && kind != 1) {
            float* rl = (float*)(shm + 131072 + 1024 + 10240);
            for (int i = otid(); i < 2048; i += 512) rl[i] = E.ropec[i];
            __syncthreads();
        }
        run_gemm(shm, A, Bt, M, N, K, E);
        {
            int cl = -1, which = 0;
            if (s == 1 && l >= 1) { cl = l; which = 8; }
            else if (s == 4 && l <= 2) { cl = l + 1; which = 1; }
            else if (s == 10 && l <= 2) { cl = l + 1; which = 6; }
            if (cl >= 0) {
                const int nwg = (M >> 8) * (N >> 8), G = (int)gridDim.x, rem = nwg % G, c = (int)blockIdx.x;
                if (rem == 0) phase_convert(a, shm, cl, which, c, G);
                else if (c >= rem) phase_convert(a, shm, cl, which, c - rem, G - rem);
            }
        }
        return;
    }
    switch (s) {
    case 0:
        phase_convert(a, shm, 0, 15, (int)blockIdx.x, (int)gridDim.x);
        {
            float* HG = (float*)(a.ws + WS_HG); const float* modb = (const float*)(a.ws + WS_MOD);
            for (int i = blockIdx.x * 512 + otid(); i < 2 * 4 * 9 * 1024; i += gridDim.x * 512) {
                const int c = i & 1023, rb = (i >> 10) % 9, tl = i / (9 * 1024), ll = tl & 3, t = tl >> 2, kk = ll % 3;
                const float g = t ? a.in[lbase(ll) + off_wout(kk) + 1][c] : a.in[lbase(ll) + 2][c];
                HG[i] = g * (1.0f + modb[(size_t)(ll * 9 + rb) * 6144 + (t ? 4096 : 1024) + c]);
            }
        }
        phase_prenorm(Xl, Xc, a.in[bs + 2], mod_l, 1024, H, ssq1, MROWS);
        break;
    case 2:
#ifndef NO_DA
        if (kind == 0) phase_da(a, shm, l, need_ctx);
#endif
#ifndef NO_ML
        if (kind == 1) phase_mlstm(a, shm);
#endif
#ifndef NO_SWA
        if (kind == 2) phase_swa(a, shm, l, need_ctx);
#endif
        break;
    case 3:
        phase_ml_finish(a, l, Mff);
        break;
    case 7:
        phase_conv_fix(a, l, Mff);
        break;
    }
}

__global__ void __launch_bounds__(512, 2) mega_fwd(Args a) {
    extern __shared__ __attribute__((aligned(16))) char shm[];
    volatile LAS unsigned* st = (volatile LAS unsigned*)((LAS char*)shm + 131072 + 256);
    if (otid() == 0) { st[0] = 0u; st[1] = 0u; }
    __syncthreads();
    XcdBarrier xb = xcd_barrier_post((unsigned*)(a.ws + WS_BAR), st);
    for (int ph = a.ph_lo; ph < a.ph_hi; ++ph) {
        if (!phase_active(ph)) continue;
        int reps = 1;
#ifdef PROBE_REP
        if (ph > 0 && ph < 45) {
            const int l_ = (ph - 1) / 11, s_ = (ph - 1) % 11, k_ = l_ % 3;
            bool rep = false;
            if (PROBE_REP == 1) rep = (s_ == 1);
            if (PROBE_REP == 2) rep = (s_ == 6);
            if (PROBE_REP == 3) rep = (s_ == 2 && k_ == 0);
            if (PROBE_REP == 4) rep = (s_ == 2 && k_ != 0) || s_ == 3;
            if (PROBE_REP == 5) rep = (s_ == 7);
            if (rep) reps = 2;
        }
#endif
        for (int r = 0; r < reps; ++r) {
            run_phase(a, shm, ph);
            if (a.use_sync && (ph + 1 < a.ph_hi || r + 1 < reps)) {
                if (a.use_sync == 2) cg::this_grid().sync();
                xcd_barrier(xb);
            }
        }
    }
}

extern "C" void kernel_launch(void* const* d_in, const int* in_sizes, int n_in, void* d_out, int out_size, void* d_ws, size_t ws_size, hipStream_t stream) {
    static int grid_blocks = 0;
    if (!grid_blocks) {
        int dev = 0, cus = 0, per_cu = 0;
        hipGetDevice(&dev);
        hipDeviceGetAttribute(&cus, hipDeviceAttributeMultiprocessorCount, dev);
        hipFuncSetAttribute((const void*)mega_fwd, hipFuncAttributeMaxDynamicSharedMemorySize, LDS_BYTES);
        hipOccupancyMaxActiveBlocksPerMultiprocessor(&per_cu, mega_fwd, 512, LDS_BYTES);
        if (per_cu < 1) { fprintf(stderr, "occupancy query returned %d\n", per_cu); per_cu = 1; }
        grid_blocks = cus * 1;
    }
    Args a{};
    for (int i = 0; i < 58; ++i) a.in[i] = (const float*)d_in[i];
    a.out = (float*)d_out; a.ws = (unsigned char*)d_ws; a.pad = 0;
#if MK_ONE_LAUNCH
    a.ph_lo = 0; a.ph_hi = NPHASE; a.use_sync = 1;
    hipMemsetAsync((char*)d_ws + WS_BAR, 0, ZERO_BYTES, stream);
    void* args[] = {&a};
    hipError_t e = hipLaunchCooperativeKernel((const void*)mega_fwd, dim3(grid_blocks), dim3(512), args, LDS_BYTES, stream);
    if (e != hipSuccess) fprintf(stderr, "cooperative launch failed: %s (grid %d)\n", hipGetErrorString(e), grid_blocks);
#else
    a.use_sync = 0;
    for (int ph = 0; ph < NPHASE; ++ph) {
        if (!phase_active(ph)) continue;
        a.ph_lo = ph; a.ph_hi = ph + 1;
        hipLaunchKernelGGL(mega_fwd, dim3(grid_blocks), dim3(512), LDS_BYTES, stream, a);
    }
#endif
}
```
